# Optimizing an MI355X kernel written in HIP

```python
import math
import jax
import jax.numpy as jnp
from jax import lax
import numpy as np

D_MODEL = 2048
BATCH = 4
SEQ = 4096
DEPTH = 4

GRID_W = 64
CTX_LEN = 256
N_MIXERS = 3
EXPAND = 2
D_INNER = EXPAND * D_MODEL
CONV_W = 3
DIFF_HEADS = D_INNER // 128
DIFF_HEAD_DIM = 64
DIFF_V_DIM = 2 * DIFF_HEAD_DIM
WIN_HEAD_DIM = 128
WIN_HEADS = D_INNER // WIN_HEAD_DIM
WIN_KV_HEADS = 8
WIN_GROUP = WIN_HEADS // WIN_KV_HEADS
WINDOW = 128
BLOCK = 128
ROPE_BASE = 10000.0
EPS = 1e-6
NEG_INF = -1e30

kernel_name = "hybrid_interleaved_dit_block"


def rms_norm(t, g, eps=EPS):
    tf = t.astype(jnp.float32)
    y = tf * lax.rsqrt(jnp.mean(tf * tf, axis=-1, keepdims=True) + eps)
    return (y * g.astype(jnp.float32)).astype(t.dtype)


def modulation(cvec, w_mod, b_mod):
    m = jax.nn.silu(cvec) @ w_mod + b_mod
    return jnp.split(m, 3, axis=-1)


def axial_rope_tables(rows, head_dim, dtype):
    row = jnp.repeat(jnp.arange(rows), GRID_W).astype(jnp.float32)
    col = jnp.tile(jnp.arange(GRID_W), rows).astype(jnp.float32)
    n_freq = head_dim // 4
    inv_freq = ROPE_BASE ** (-(jnp.arange(n_freq, dtype=jnp.float32) / n_freq))
    ang = jnp.concatenate([row[:, None] * inv_freq, col[:, None] * inv_freq], axis=-1)
    return jnp.cos(ang).astype(dtype), jnp.sin(ang).astype(dtype)


def apply_axial_rope(t, cos, sin):
    d = t.shape[-1]
    q4 = d // 4
    tr = t.reshape(t.shape[:-1] + (2, 2, q4))
    t1, t2 = tr[..., 0, :], tr[..., 1, :]
    bshape = (cos.shape[0],) + (1,) * (t.ndim - 3) + (2, q4)
    cs, sn = cos.reshape(bshape), sin.reshape(bshape)
    return jnp.stack([t1 * cs - t2 * sn, t1 * sn + t2 * cs], axis=-2).reshape(t.shape)


def short_conv_branch(h, w_in, conv_w, conv_b, w_out):
    b_gate, c_gate, xt, z = jnp.split(h @ w_in, 4, axis=-1)
    u = c_gate * xt
    n = u.shape[1]
    half = CONV_W // 2
    up = jnp.pad(u, ((0, 0), (half, half), (0, 0)))
    y = sum(up[:, k:k + n] * conv_w[k] for k in range(CONV_W)) + conv_b
    return (b_gate * y * jax.nn.silu(z)) @ w_out


def short_conv_mixer(h, hc, params, need_ctx_out):
    w_in, conv_w, conv_b, w_out = params
    y = short_conv_branch(h, w_in, conv_w, conv_b, w_out)
    yc = short_conv_branch(hc, w_in, conv_w, conv_b, w_out) if need_ctx_out else None
    return y, yc


def _diff_heads(t, g, rope):
    B, L = t.shape[:2]
    t = rms_norm(t.reshape(B, L, DIFF_HEADS, 2, DIFF_HEAD_DIM), g).swapaxes(2, 3)
    if rope is not None:
        t = apply_axial_rope(t, *rope)
    return t


def diff_project(h, w_in, q_norm, k_norm, rope, kv_only):
    B, L, _ = h.shape
    if kv_only:
        k, v = jnp.split(h @ w_in[:, D_INNER:3 * D_INNER], 2, axis=-1)
        q = z = None
    else:
        q, k, v, z = jnp.split(h @ w_in, 4, axis=-1)
        q = _diff_heads(q, q_norm, rope)
    k = _diff_heads(k, k_norm, rope)
    v = v.reshape(B, L, DIFF_HEADS, DIFF_V_DIM)
    return q, k, v, z


def diff_attend(q, k, v, lam):
    s = jnp.einsum("bqmhd,bkmhd->bmhqk", q, k).astype(jnp.float32) * (DIFF_HEAD_DIM ** -0.5)
    p = jax.nn.softmax(s, axis=-1)
    w = p[:, 0] - lam * p[:, 1]
    return jnp.einsum("bhqk,bkhe->bqhe", w.astype(v.dtype), v)


def diff_finish(o, z, sub_norm, lam_init, w_out):
    B, L = o.shape[:2]
    o = rms_norm(o, sub_norm) * (1.0 - lam_init)
    return (o.reshape(B, L, D_INNER) * jax.nn.silu(z)) @ w_out


def diff_attention_mixer(h, hc, params, layer_idx, need_ctx_out, rope):
    w_in, q_norm, k_norm, lq1, lk1, lq2, lk2, sub_norm, w_out = params
    f32 = jnp.float32
    lam_init = 0.8 - 0.6 * math.exp(-0.3 * layer_idx)
    lam = (jnp.exp(jnp.sum(lq1.astype(f32) * lk1.astype(f32)))
           - jnp.exp(jnp.sum(lq2.astype(f32) * lk2.astype(f32))) + lam_init)
    B, L, _ = h.shape
    q, k, v, z = diff_project(h, w_in, q_norm, k_norm, rope, False)
    qc, kc, vc, zc = diff_project(hc, w_in, q_norm, k_norm, None, not need_ctx_out)
    k_all = jnp.concatenate([k, kc], axis=1)
    v_all = jnp.concatenate([v, vc], axis=1)

    def block(i):
        qb = lax.dynamic_slice_in_dim(q, i * BLOCK, BLOCK, axis=1)
        return diff_attend(qb, k_all, v_all, lam)

    o = lax.map(block, jnp.arange(L // BLOCK))
    o = jnp.moveaxis(o, 0, 1).reshape(B, L, DIFF_HEADS, DIFF_V_DIM)
    y = diff_finish(o, z, sub_norm, lam_init, w_out)
    yc = None
    if need_ctx_out:
        oc = diff_attend(qc, kc, vc, lam)
        yc = diff_finish(oc, zc, sub_norm, lam_init, w_out)
    return y, yc


def win_project(h, w_in, q_norm, k_norm, rope, kv_only):
    B, L, _ = h.shape
    kv_w = WIN_KV_HEADS * WIN_HEAD_DIM
    if kv_only:
        k, v = jnp.split(h @ w_in[:, D_INNER:D_INNER + 2 * kv_w], 2, axis=-1)
        q = z = None
    else:
        q, k, v, z = jnp.split(h @ w_in, [D_INNER, D_INNER + kv_w, D_INNER + 2 * kv_w], axis=-1)
        q = rms_norm(q.reshape(B, L, WIN_KV_HEADS, WIN_GROUP, WIN_HEAD_DIM), q_norm)
        if rope is not None:
            q = apply_axial_rope(q, *rope)
    k = rms_norm(k.reshape(B, L, WIN_KV_HEADS, WIN_HEAD_DIM), k_norm)
    if rope is not None:
        k = apply_axial_rope(k, *rope)
    v = v.reshape(B, L, WIN_KV_HEADS, WIN_HEAD_DIM)
    return q, k, v, z


def window_gqa_mixer(h, hc, params, need_ctx_out, rope):
    w_in, q_norm, k_norm, sink, w_out = params
    f32 = jnp.float32
    B, L, _ = h.shape
    scale = WIN_HEAD_DIM ** -0.5
    q, k, v, z = win_project(h, w_in, q_norm, k_norm, rope, False)
    qc, kc, vc, zc = win_project(hc, w_in, q_norm, k_norm, None, not need_ctx_out)
    n_ctx = kc.shape[1]
    sink_logit = sink.astype(f32).reshape(WIN_KV_HEADS, WIN_GROUP, 1, 1)
    pad = ((0, 0), (BLOCK, BLOCK), (0, 0), (0, 0))
    kp, vp = jnp.pad(k, pad), jnp.pad(v, pad)
    band = 3 * BLOCK
    offset = jnp.arange(BLOCK)[:, None] + BLOCK - jnp.arange(band)[None, :]
    in_window = jnp.abs(offset) <= WINDOW

    def block(i):
        qb = lax.dynamic_slice_in_dim(q, i * BLOCK, BLOCK, axis=1)
        kb = lax.dynamic_slice_in_dim(kp, i * BLOCK, band, axis=1)
        vb = lax.dynamic_slice_in_dim(vp, i * BLOCK, band, axis=1)
        kpos = i * BLOCK - BLOCK + jnp.arange(band)
        valid = in_window & ((kpos >= 0) & (kpos < L))[None, :]
        s_band = jnp.einsum("bqngd,bknd->bngqk", qb, kb).astype(f32) * scale
        s_band = jnp.where(valid, s_band, NEG_INF)
        s_ctx = jnp.einsum("bqngd,bknd->bngqk", qb, kc).astype(f32) * scale
        s_sink = jnp.broadcast_to(sink_logit, s_band.shape[:-1] + (1,))
        p = jax.nn.softmax(jnp.concatenate([s_band, s_ctx, s_sink], axis=-1), axis=-1)
        p_band = p[..., :band].astype(v.dtype)
        p_ctx = p[..., band:band + n_ctx].astype(v.dtype)
        return (jnp.einsum("bngqk,bknd->bqngd", p_band, vb)
                + jnp.einsum("bngqk,bknd->bqngd", p_ctx, vc))

    o = lax.map(block, jnp.arange(L // BLOCK))
    o = jnp.moveaxis(o, 0, 1).reshape(B, L, D_INNER)
    y = (o * jax.nn.silu(z)) @ w_out
    yc = None
    if need_ctx_out:
        s = jnp.einsum("bqngd,bknd->bngqk", qc, kc).astype(f32) * scale
        s_sink = jnp.broadcast_to(sink_logit, s.shape[:-1] + (1,))
        p = jax.nn.softmax(jnp.concatenate([s, s_sink], axis=-1), axis=-1)[..., :n_ctx]
        oc = jnp.einsum("bngqk,bknd->bqngd", p.astype(vc.dtype), vc).reshape(B, n_ctx, D_INNER)
        yc = (oc * jax.nn.silu(zc)) @ w_out
    return y, yc


def setup_inputs(seed: int = 0) -> dict:
    key = jax.random.key(seed)
    keys = iter(jax.random.split(key, 64))

    def rnd(shape, scale):
        return jax.random.normal(next(keys), shape, dtype=jnp.float32) * scale

    d_scale = D_MODEL ** -0.5
    e_scale = D_INNER ** -0.5
    kv_w = WIN_KV_HEADS * WIN_HEAD_DIM
    inp = {
        "x": rnd((BATCH, SEQ, D_MODEL), 1.0),
        "c": rnd((BATCH, D_MODEL), 1.0),
        "ctx": rnd((BATCH, CTX_LEN, D_MODEL), 1.0),
        "c_ctx": rnd((D_MODEL,), 1.0),
    }
    for i in range(DEPTH):
        p = f"l{i}_"
        kind = i % N_MIXERS
        inp[p + "norm"] = 1.0 + rnd((D_MODEL,), 0.05)
        inp[p + "w_mod"] = rnd((D_MODEL, 3 * D_MODEL), 0.5 * d_scale)
        inp[p + "b_mod"] = rnd((3 * D_MODEL,), 0.02)
        if kind == 0:
            inp[p + "w_in"] = rnd((D_MODEL, 4 * D_INNER), d_scale)
            inp[p + "conv_w"] = rnd((CONV_W, D_INNER), CONV_W ** -0.5)
            inp[p + "conv_b"] = rnd((D_INNER,), 0.02)
        elif kind == 1:
            inp[p + "w_in"] = rnd((D_MODEL, 4 * D_INNER), d_scale)
            inp[p + "q_norm"] = 1.0 + rnd((DIFF_HEAD_DIM,), 0.05)
            inp[p + "k_norm"] = 1.0 + rnd((DIFF_HEAD_DIM,), 0.05)
            inp[p + "lam_q1"] = rnd((DIFF_HEAD_DIM,), 0.1)
            inp[p + "lam_k1"] = rnd((DIFF_HEAD_DIM,), 0.1)
            inp[p + "lam_q2"] = rnd((DIFF_HEAD_DIM,), 0.1)
            inp[p + "lam_k2"] = rnd((DIFF_HEAD_DIM,), 0.1)
            inp[p + "sub_norm"] = 1.0 + rnd((DIFF_V_DIM,), 0.05)
        else:
            inp[p + "w_in"] = rnd((D_MODEL, 2 * D_INNER + 2 * kv_w), d_scale)
            inp[p + "q_norm"] = 1.0 + rnd((WIN_HEAD_DIM,), 0.05)
            inp[p + "k_norm"] = 1.0 + rnd((WIN_HEAD_DIM,), 0.05)
            inp[p + "sink"] = rnd((WIN_HEADS,), 1.0)
        inp[p + "w_out"] = rnd((D_INNER, D_MODEL), e_scale)
    return inp


def reference(x, c, ctx, c_ctx,
              l0_norm, l0_w_mod, l0_b_mod, l0_w_in, l0_conv_w, l0_conv_b, l0_w_out,
              l1_norm, l1_w_mod, l1_b_mod, l1_w_in, l1_q_norm, l1_k_norm,
              l1_lam_q1, l1_lam_k1, l1_lam_q2, l1_lam_k2, l1_sub_norm, l1_w_out,
              l2_norm, l2_w_mod, l2_b_mod, l2_w_in, l2_q_norm, l2_k_norm, l2_sink, l2_w_out,
              l3_norm, l3_w_mod, l3_b_mod, l3_w_in, l3_conv_w, l3_conv_b, l3_w_out):
    n_tok = x.shape[1]
    rows = n_tok // GRID_W
    rope_diff = axial_rope_tables(rows, DIFF_HEAD_DIM, x.dtype)
    rope_win = axial_rope_tables(rows, WIN_HEAD_DIM, x.dtype)
    layers = [
        (l0_norm, l0_w_mod, l0_b_mod, (l0_w_in, l0_conv_w, l0_conv_b, l0_w_out)),
        (l1_norm, l1_w_mod, l1_b_mod, (l1_w_in, l1_q_norm, l1_k_norm, l1_lam_q1, l1_lam_k1,
                                       l1_lam_q2, l1_lam_k2, l1_sub_norm, l1_w_out)),
        (l2_norm, l2_w_mod, l2_b_mod, (l2_w_in, l2_q_norm, l2_k_norm, l2_sink, l2_w_out)),
        (l3_norm, l3_w_mod, l3_b_mod, (l3_w_in, l3_conv_w, l3_conv_b, l3_w_out)),
    ]
    for i in range(DEPTH):
        norm_g, w_mod, b_mod, mix_p = layers[i]
        kind = i % N_MIXERS
        reads_ctx = kind != 0
        need_ctx_out = any((j % N_MIXERS) != 0 for j in range(i + 1, DEPTH))
        shift, scale, gate = modulation(c, w_mod, b_mod)
        h = rms_norm(x, norm_g) * (1 + scale[:, None, :]) + shift[:, None, :]
        hc = None
        if reads_ctx or need_ctx_out:
            shift_c, scale_c, gate_c = modulation(c_ctx, w_mod, b_mod)
            hc = rms_norm(ctx, norm_g) * (1 + scale_c) + shift_c
        if kind == 0:
            y, yc = short_conv_mixer(h, hc, mix_p, need_ctx_out)
        elif kind == 1:
            y, yc = diff_attention_mixer(h, hc, mix_p, i, need_ctx_out, rope_diff)
        else:
            y, yc = window_gqa_mixer(h, hc, mix_p, need_ctx_out, rope_win)
        x = x + gate[:, None, :] * y
        if need_ctx_out:
            ctx = ctx + gate_c * yc
    return x
```

```cpp
#include <hip/hip_runtime.h>
#include <hip/hip_cooperative_groups.h>
#include <cstdio>
#include <cstdint>
#define MK_SINGLE 1
namespace pg8 {
#define PG8_LAS __attribute__((address_space(3)))
typedef unsigned short bf16_t;
typedef short bf16x8 __attribute__((ext_vector_type(8)));
typedef float f32x4 __attribute__((ext_vector_type(4)));
typedef unsigned u32x4 __attribute__((ext_vector_type(4)));
constexpr int BM = 256, BK = 64, HALF = 128, HTB = HALF * BK * 2  , STAGE_BYTES = 8 * HTB, NXCD = 8, WGM = 8;

__host__ __device__ __forceinline__ int lds_byte(int r, int c) { const int st = (r >> 4) * 2 + (c >> 5), rr = r & 15, cc = c & 31, ob = rr * 64 + cc * 2; return st * 1024 + (ob ^ (((ob >> 9) & 1) << 5)); }
__host__ __device__ __forceinline__ void stage_rc(int b, int& R, int& C) { const int st = b / 1024, sb = b % 1024, swz = sb ^ (((sb >> 9) & 1) << 5); R = (st >> 1) * 16 + swz / 64; C = (st & 1) * 32 + (swz % 64) / 2; }
__host__ __device__ __forceinline__ int perm32(int rho) { const int n = rho >> 4, i = rho & 15; return 8 * (i >> 2) + 4 * n + (i & 3); }

struct Unit { int pm, pn, ko; };
struct Gemm { const bf16_t* A; const bf16_t* Bt; int M, N, K; int ld = 0; };

struct StaticOrder {
    int nM, nN, nwg, G, c;
    __host__ __device__ void init(int M, int N, int G_, int c_) { nM = M / BM; nN = N / BM; nwg = nM * nN; G = G_; c = c_; }
    __host__ __device__ bool next(int i, Unit& u) const {
        const long L = (long)i * G + c; if (L >= nwg) return false;
        int wgid = (int)L; { const int q = nwg / NXCD, r = nwg % NXCD, xcd = wgid % NXCD, off = wgid / NXCD; wgid = (xcd < r ? xcd * (q + 1) : r * (q + 1) + (xcd - r) * q) + off; }
        const int nig = WGM * nN, gid = wgid / nig, fm = gid * WGM, gsz = (nM - fm) < WGM ? (nM - fm) : WGM;
        u.pm = fm + ((wgid % nig) % gsz); u.pn = (wgid % nig) / gsz; u.ko = 0; return true;
    }
    __device__ __forceinline__ void a_ready(const Unit&) const {}
    __device__ __forceinline__ void done(const Unit&) const {}
};
struct SplitOrder {
    int c, G;
    __host__ __device__ bool next(int i, Unit& u) const { const int L = i * G + c; if (L >= 256) return false; u.pm = 64 + (L >> 6); u.pn = (L >> 3) & 7; u.ko = (L & 7) * 512; return true; }
    __device__ __forceinline__ void a_ready(const Unit&) const {}
    __device__ __forceinline__ void done(const Unit&) const {}
};
__device__ __forceinline__ unsigned cvt_pk_bf16(float lo, float hi) { unsigned r; asm volatile("v_cvt_pk_bf16_f32 %0, %1, %2" : "=v"(r) : "v"(lo), "v"(hi)); return r; }
typedef float f32x2 __attribute__((ext_vector_type(2)));
typedef unsigned u32x2 __attribute__((ext_vector_type(2)));
#define PG8_GAS __attribute__((address_space(1)))
__device__ __forceinline__ float silu_f(float z) { return z * __builtin_amdgcn_rcpf(1.0f + __builtin_amdgcn_exp2f(-1.4426950408889634f * z)); }

template <int KIND, long SLOT, long MROWS> struct EpiSplit {
    static constexpr bool PERM = false, AFTER_DRAIN = false;
    bf16_t* base;
    __device__ __forceinline__ void operator()(const f32x4 (&acc)[2][2][4][2], const Unit& u, int wr, int wc, int fr, int fq) const {
        const int pn = u.pn; long boff; int ld, tt;
        if (KIND == 1) { const int s = pn >> 4; boff = (long)s * SLOT; ld = 4096; tt = s << 4; }
        else { if (pn < 16) { boff = 0; ld = 4096; tt = 0; } else if (pn < 20) { boff = SLOT; ld = 1024; tt = 16; } else if (pn < 24) { boff = SLOT + MROWS * 1024; ld = 1024; tt = 20; } else { boff = 3 * SLOT; ld = 4096; tt = 24; } }
        const int row0 = u.pm * BM + wr * 64 + fr, col0 = (pn - tt) * BM + wc * 32 + 8 * fq;
        bf16_t* B = base + boff + (size_t)row0 * ld + col0;
#pragma unroll
        for (int ai = 0; ai < 2; ++ai)
#pragma unroll
            for (int m = 0; m < 4; ++m) { bf16_t* rowp = B + (size_t)((ai * HALF + m * 16) * ld);
#pragma unroll
                for (int bj = 0; bj < 2; ++bj) { const f32x4 v0 = acc[ai][bj][m][0], v1 = acc[ai][bj][m][1];
                    u32x4 w; w.x = cvt_pk_bf16(v0[0], v0[1]); w.y = cvt_pk_bf16(v0[2], v0[3]); w.z = cvt_pk_bf16(v1[0], v1[1]); w.w = cvt_pk_bf16(v1[2], v1[3]);
                    *(PG8_GAS u32x4*)(rowp + bj * HALF) = w; } }
    }
};
struct EpiConv {
    static constexpr bool PERM = false, AFTER_DRAIN = false;
    bf16_t* U; bf16_t* BZ;
    __device__ __forceinline__ void operator()(const f32x4 (&acc)[2][2][4][2], const Unit& u, int wr, int wc, int fr, int fq) const {
        const int row0 = u.pm * BM + wr * 64 + fr, col0 = u.pn * 64 + wc * 16 + 4 * fq;
#pragma unroll
        for (int ai = 0; ai < 2; ++ai)
#pragma unroll
            for (int m = 0; m < 4; ++m) { const size_t off = (size_t)(row0 + ai * HALF + m * 16) * 4096 + col0;
                const f32x4 bg = acc[ai][0][m][0], cg = acc[ai][0][m][1], xt = acc[ai][1][m][0], z = acc[ai][1][m][1];
                const f32x4 uu = cg * xt; f32x4 bz; bz[0] = bg[0] * silu_f(z[0]); bz[1] = bg[1] * silu_f(z[1]); bz[2] = bg[2] * silu_f(z[2]); bz[3] = bg[3] * silu_f(z[3]);
                u32x2 a; a.x = cvt_pk_bf16(uu[0], uu[1]); a.y = cvt_pk_bf16(uu[2], uu[3]); *(PG8_GAS u32x2*)(U + off) = a;
                u32x2 b; b.x = cvt_pk_bf16(bz[0], bz[1]); b.y = cvt_pk_bf16(bz[2], bz[3]); *(PG8_GAS u32x2*)(BZ + off) = b; }
    }
};
struct EpiResid {
    static constexpr bool PERM = false, AFTER_DRAIN = false;
    const float* xin; float* xout; const float* mod;
    __device__ __forceinline__ void operator()(const f32x4 (&acc)[2][2][4][2], const Unit& u, int wr, int wc, int fr, int fq) const {
        const float* src = xin + (size_t)u.pm * BM * 2048; float* dst = xout + (size_t)u.pm * BM * 2048;
        const float* gate = mod + (u.pm >> 4) * 6144 + 4096;
        const int rl = wr * 64 + fr, col0 = u.pn * BM + wc * 32 + 4 * fq;
        f32x4 gv[2][2];
#pragma unroll
        for (int bj = 0; bj < 2; ++bj)
#pragma unroll
            for (int n = 0; n < 2; ++n) gv[bj][n] = *(const PG8_GAS f32x4*)(gate + col0 + bj * HALF + n * 16);
#pragma unroll
        for (int ai = 0; ai < 2; ++ai)
#pragma unroll
            for (int mp = 0; mp < 2; ++mp) { f32x4 xs[2][2][2];
#pragma unroll
                for (int mm = 0; mm < 2; ++mm) { const size_t off = (size_t)(rl + ai * HALF + (2 * mp + mm) * 16) * 2048 + col0;
#pragma unroll
                    for (int bj = 0; bj < 2; ++bj)
#pragma unroll
                        for (int n = 0; n < 2; ++n) xs[mm][bj][n] = *(const PG8_GAS f32x4*)(src + off + bj * HALF + n * 16); }
#pragma unroll
                for (int mm = 0; mm < 2; ++mm) { const size_t off = (size_t)(rl + ai * HALF + (2 * mp + mm) * 16) * 2048 + col0;
#pragma unroll
                    for (int bj = 0; bj < 2; ++bj)
#pragma unroll
                        for (int n = 0; n < 2; ++n) *(PG8_GAS f32x4*)(dst + off + bj * HALF + n * 16) = xs[mm][bj][n] + gv[bj][n] * acc[ai][bj][2 * mp + mm][n]; }
                asm volatile("" ::: "memory"); }
    }
};
struct EpiSlab {
    static constexpr bool PERM = false, AFTER_DRAIN = false;
    float* slab;
    __device__ __forceinline__ void operator()(const f32x4 (&acc)[2][2][4][2], const Unit& u, int wr, int wc, int fr, int fq) const {
        float* dst = slab + ((size_t)(u.ko >> 9) * 1024 + (size_t)(u.pm - 64) * BM) * 2048;
        const int rl = wr * 64 + fr, col0 = u.pn * BM + wc * 32 + 4 * fq;
#pragma unroll
        for (int ai = 0; ai < 2; ++ai)
#pragma unroll
            for (int m = 0; m < 4; ++m) { const size_t off = (size_t)(rl + ai * HALF + m * 16) * 2048 + col0;
#pragma unroll
                for (int bj = 0; bj < 2; ++bj)
#pragma unroll
                    for (int n = 0; n < 2; ++n) *(PG8_GAS f32x4*)(dst + off + bj * HALF + n * 16) = acc[ai][bj][m][n]; }
    }
};
template <class Epi, class Sched, bool ALIGN_EPI = false, bool SP2 = false>
__device__ __forceinline__ void gemm_phase(PG8_LAS unsigned char* lds, const Gemm g, const Sched& S, const Epi& E) {
    int tid_ = threadIdx.x; asm volatile("" : "+v"(tid_));
    const int tid = tid_, wid = __builtin_amdgcn_readfirstlane(tid >> 6), lane = tid & 63, wr = wid >> 2, wc = wid & 3, fr = lane & 15, fq = lane >> 4;
    const int K = g.K, nt = K / BK, LD = g.ld ? g.ld : g.K;
    unsigned voffA[2], voffB[2];
#pragma unroll
    for (int i = 0; i < 2; ++i) { int R, C; stage_rc(tid * 16 + i * 8192, R, C); const int Rb = Epi::PERM ? ((R & ~31) + perm32(R & 31)) : R;
        voffA[i] = (unsigned)(R * LD + C) * 2u; voffB[i] = (unsigned)(Rb * LD + C) * 2u; }
    const size_t kstep = (size_t)(BK * 2);
    const size_t hstep = (size_t)HALF * LD * 2;
    const size_t tstep = 2 * hstep;
    const unsigned ldsw = (unsigned)wid * 1024u;
    const int aoff = lds_byte(wr * 64 + fr, fq * 8), boff = lds_byte(wc * 32 + fr, fq * 8);
#define PG8_SA(b, h) (((b) * 2 + (h)) * HTB)
#define PG8_SB(b, h) ((4 + (b) * 2 + (h)) * HTB)
#define PG8_STAGE(bufoff, gbase, voff) do { _Pragma("unroll") for (int _i = 0; _i < 2; ++_i) \
        __builtin_amdgcn_global_load_lds((const unsigned*)((const char*)(gbase) + (voff)[_i]), (PG8_LAS unsigned*)(lds + (bufoff) + ldsw + _i * 8192), 16, 0, 0); } while (0)
#define PG8_LDA(dst, b, h) do { _Pragma("unroll") for (int m = 0; m < 4; ++m) _Pragma("unroll") for (int k = 0; k < 2; ++k) dst[m][k] = *(const PG8_LAS bf16x8*)(lds + PG8_SA(b, h) + aoff + m * 2048 + k * 1024); } while (0)
#define PG8_LDB(dst, b, h) do { _Pragma("unroll") for (int n = 0; n < 2; ++n) _Pragma("unroll") for (int k = 0; k < 2; ++k) dst[n][k] = *(const PG8_LAS bf16x8*)(lds + PG8_SB(b, h) + boff + n * 2048 + k * 1024); } while (0)
#define PG8_MMA(ai, bj, At, Bt) do { __builtin_amdgcn_s_setprio(1); _Pragma("unroll") for (int m = 0; m < 4; ++m) _Pragma("unroll") for (int n = 0; n < 2; ++n) _Pragma("unroll") for (int k = 0; k < 2; ++k) \
        acc[ai][bj][m][n] = __builtin_amdgcn_mfma_f32_16x16x32_bf16(Bt[n][k], At[m][k], acc[ai][bj][m][n], 0, 0, 0); __builtin_amdgcn_s_setprio(0); } while (0)
#define PG8_WAIT_V(n) asm volatile("s_waitcnt vmcnt(" #n ")" ::: "memory")
#define PG8_WAIT_L(n) asm volatile("s_waitcnt lgkmcnt(" #n ")" ::: "memory")
#define PG8_BAR __builtin_amdgcn_s_barrier()
#define PG8_SCHED __builtin_amdgcn_sched_barrier(0)
    Unit cur, nxt; int ui = 0;
    if (!S.next(0, cur)) return;
    f32x4 acc[2][2][4][2];
#pragma unroll
    for (int a = 0; a < 2; ++a)
#pragma unroll
        for (int b = 0; b < 2; ++b)
#pragma unroll
            for (int m = 0; m < 4; ++m)
#pragma unroll
                for (int n = 0; n < 2; ++n) acc[a][b][m][n] = (f32x4){0.f, 0.f, 0.f, 0.f};
    bf16x8 At[4][2], B0[2][2], B1[2][2];
    const char* cA = (const char*)g.A + (size_t)cur.pm * tstep + (size_t)cur.ko * 2; const char* cB = (const char*)g.Bt + (size_t)cur.pn * tstep + (size_t)cur.ko * 2;
    S.a_ready(cur);
    if constexpr (SP2) {
        PG8_STAGE(PG8_SB(0, 0), cB, voffB); PG8_STAGE(PG8_SB(0, 1), cB + hstep, voffB); PG8_STAGE(PG8_SA(0, 0), cA, voffA); PG8_STAGE(PG8_SA(0, 1), cA + hstep, voffA);
        if (wr == 1) PG8_BAR;
        PG8_WAIT_V(2); PG8_BAR;
        PG8_STAGE(PG8_SB(1, 0), cB + kstep, voffB); PG8_STAGE(PG8_SA(1, 0), cA + kstep, voffA); PG8_STAGE(PG8_SB(1, 1), cB + hstep + kstep, voffB);
        PG8_WAIT_V(6); PG8_BAR;
    } else {
        PG8_STAGE(PG8_SB(0, 0), cB, voffB); PG8_STAGE(PG8_SA(0, 0), cA, voffA); PG8_STAGE(PG8_SB(0, 1), cB + hstep, voffB); PG8_STAGE(PG8_SA(0, 1), cA + hstep, voffA);
        if (wr == 1) PG8_BAR;
        PG8_WAIT_V(4); PG8_BAR;
        PG8_STAGE(PG8_SB(1, 0), cB + kstep, voffB); PG8_STAGE(PG8_SA(1, 0), cA + kstep, voffA); PG8_STAGE(PG8_SB(1, 1), cB + hstep + kstep, voffB);
        PG8_WAIT_V(6); PG8_BAR;
    }
    for (;;) {
        const bool has_next = S.next(ui + 1, nxt);
        const char* nA = has_next ? (const char*)g.A + (size_t)nxt.pm * tstep + (size_t)nxt.ko * 2 : cA; const char* nB = has_next ? (const char*)g.Bt + (size_t)nxt.pn * tstep + (size_t)nxt.ko * 2 : cB;
        for (int t = 0; t < nt; t += 2) {
            const bool last = (t == nt - 2);
            const char* a1 = cA + (size_t)(t + 1) * kstep;
            const char* a2 = last ? nA : cA + (size_t)(t + 2) * kstep; const char* b2 = last ? nB : cB + (size_t)(t + 2) * kstep;
            const char* a3 = a2 + kstep; const char* b3 = b2 + kstep;
            if (last && has_next) S.a_ready(nxt);
            if constexpr (SP2) {
            PG8_LDB(B0, 0, 0); PG8_LDB(B1, 0, 1); PG8_SCHED; PG8_LDA(At, 0, 0); PG8_STAGE(PG8_SA(1, 1), a1 + hstep, voffA);
            PG8_WAIT_V(8); PG8_WAIT_L(0); PG8_BAR; PG8_MMA(0, 0, At, B0); PG8_MMA(0, 1, At, B1); PG8_BAR; PG8_SCHED;
            PG8_LDA(At, 0, 1); PG8_STAGE(PG8_SB(0, 0), b2, voffB); PG8_STAGE(PG8_SB(0, 1), b2 + hstep, voffB); PG8_STAGE(PG8_SA(0, 0), a2, voffA);
            PG8_WAIT_V(8); PG8_WAIT_L(0); PG8_BAR; PG8_MMA(1, 0, At, B0); PG8_MMA(1, 1, At, B1); PG8_BAR; PG8_SCHED;
            PG8_LDB(B0, 1, 0); PG8_LDB(B1, 1, 1); PG8_SCHED; PG8_LDA(At, 1, 0); PG8_STAGE(PG8_SA(0, 1), a2 + hstep, voffA);
            PG8_WAIT_V(8); PG8_WAIT_L(0); PG8_BAR; PG8_MMA(0, 0, At, B0); PG8_MMA(0, 1, At, B1); PG8_BAR; PG8_SCHED;
            PG8_LDA(At, 1, 1); PG8_STAGE(PG8_SB(1, 0), b3, voffB); PG8_STAGE(PG8_SB(1, 1), b3 + hstep, voffB); PG8_STAGE(PG8_SA(1, 0), a3, voffA);
            PG8_WAIT_V(8); PG8_WAIT_L(0); PG8_BAR; PG8_MMA(1, 0, At, B0); PG8_MMA(1, 1, At, B1); PG8_BAR; PG8_SCHED;
            } else {
            PG8_LDB(B0, 0, 0); PG8_SCHED; PG8_LDA(At, 0, 0); PG8_STAGE(PG8_SA(1, 1), a1 + hstep, voffA);
            PG8_WAIT_L(8); PG8_BAR; PG8_WAIT_L(0); PG8_MMA(0, 0, At, B0); PG8_BAR; PG8_SCHED;
            PG8_LDB(B1, 0, 1); PG8_STAGE(PG8_SB(0, 0), b2, voffB);
            PG8_BAR; PG8_WAIT_L(0); PG8_MMA(0, 1, At, B1); PG8_BAR;
            PG8_LDA(At, 0, 1); PG8_STAGE(PG8_SA(0, 0), a2, voffA);
            PG8_BAR; PG8_WAIT_L(0); PG8_MMA(1, 0, At, B0); PG8_BAR; PG8_SCHED;
            PG8_STAGE(PG8_SB(0, 1), b2 + hstep, voffB);
            PG8_WAIT_V(6); PG8_BAR; PG8_MMA(1, 1, At, B1); PG8_BAR;
            PG8_LDB(B0, 1, 0); PG8_SCHED; PG8_LDA(At, 1, 0); PG8_STAGE(PG8_SA(0, 1), a2 + hstep, voffA);
            PG8_WAIT_L(8); PG8_BAR; PG8_WAIT_L(0); PG8_MMA(0, 0, At, B0); PG8_BAR; PG8_SCHED;
            PG8_LDB(B1, 1, 1); PG8_STAGE(PG8_SB(1, 0), b3, voffB);
            PG8_BAR; PG8_WAIT_L(0); PG8_MMA(0, 1, At, B1); PG8_BAR;
            PG8_LDA(At, 1, 1); PG8_STAGE(PG8_SA(1, 0), a3, voffA);
            PG8_BAR; PG8_WAIT_L(0); PG8_MMA(1, 0, At, B0); PG8_BAR; PG8_SCHED;
            PG8_STAGE(PG8_SB(1, 1), b3 + hstep, voffB);
            PG8_WAIT_V(6); PG8_BAR; PG8_MMA(1, 1, At, B1); PG8_BAR;
            }
        }
        if constexpr (ALIGN_EPI) { if (wr == 0) PG8_BAR; }
        if constexpr (!Epi::AFTER_DRAIN) { E(acc, cur, wr, wc, fr, fq); S.done(cur); }
        if (!has_next) break;
#pragma unroll
        for (int a = 0; a < 2; ++a)
#pragma unroll
            for (int b = 0; b < 2; ++b)
#pragma unroll
                for (int m = 0; m < 4; ++m)
#pragma unroll
                    for (int n = 0; n < 2; ++n) acc[a][b][m][n] = (f32x4){0.f, 0.f, 0.f, 0.f};
        cur = nxt; cA = nA; cB = nB; ++ui;
        if constexpr (ALIGN_EPI) { if (wr == 1) PG8_BAR; }
    }
    PG8_WAIT_V(0);
    if constexpr (!ALIGN_EPI) { if (wr == 0) PG8_BAR; }
    PG8_BAR;
    if constexpr (Epi::AFTER_DRAIN) { E.fused(acc, cur, wr, wc, fr, fq, lds, wid, lane); S.done(cur); }
#undef PG8_SA
#undef PG8_SB
#undef PG8_STAGE
#undef PG8_LDA
#undef PG8_LDB
#undef PG8_MMA
#undef PG8_WAIT_V
#undef PG8_WAIT_L
#undef PG8_BAR
#undef PG8_SCHED
}
}
namespace cg = cooperative_groups;
#define LAS __attribute__((address_space(3)))
#define GAS __attribute__((address_space(1)))
typedef unsigned short bf16;
typedef unsigned v4u __attribute__((ext_vector_type(4)));
typedef unsigned v2u __attribute__((ext_vector_type(2)));
typedef float f32x4 __attribute__((ext_vector_type(4)));
typedef float f32x16 __attribute__((ext_vector_type(16)));
typedef short bf16x8 __attribute__((ext_vector_type(8)));
typedef short s16x4 __attribute__((ext_vector_type(4)));
typedef float f32x2_t __attribute__((ext_vector_type(2)));
typedef __bf16 bf16x2_t __attribute__((ext_vector_type(2)));

constexpr int DM = 2048, DI = 4096, SEQ = 4096, ML = 16384, MC = 1024, MT = ML + MC;
constexpr float EPS = 1e-6f, LOG2E = 1.4426950408889634f;
constexpr float LAM_INIT1 = 0.35550906f;
constexpr int NWAVES = 8, NPH = 21;
constexpr int LDS_BYTES = 147456, LDS_BARST = LDS_BYTES - 64;

constexpr size_t MiB = 1u << 20;
constexpr size_t WS_MOD = 0, MOD_ZERO_BYTES = 512 * 1024;
constexpr size_t WS_BAR = 496 * 1024;
constexpr size_t WS_TAB = 1 * MiB;
constexpr size_t WS_WTIN = 2 * MiB, WS_WTOUT = 66 * MiB;
constexpr size_t WS_HA = 82 * MiB;
constexpr size_t WS_CBUF = 150 * MiB;
constexpr size_t WS_SLOT = 160 * MiB, SLOT_BYTES = 136 * MiB;
constexpr size_t WS_SLAB = WS_SLOT + 4 * SLOT_BYTES;
constexpr size_t WS_END = WS_SLAB + 64 * MiB;

__device__ __forceinline__ unsigned f2bf(float f) { unsigned u = __builtin_bit_cast(unsigned, f); return (u + 0x7fffu + ((u >> 16) & 1u)) >> 16; }
__device__ __forceinline__ unsigned pk2(float lo, float hi) { f32x2_t v = {lo, hi}; bf16x2_t b = __builtin_convertvector(v, bf16x2_t); return __builtin_bit_cast(unsigned, b); }
__device__ __forceinline__ float bflo(unsigned w) { return __builtin_bit_cast(float, w << 16); }
__device__ __forceinline__ float bfhi(unsigned w) { return __builtin_bit_cast(float, w & 0xffff0000u); }
__device__ __forceinline__ float wave_sum(float v) {
#pragma unroll
    for (int o = 1; o < 64; o <<= 1) v += __shfl_xor(v, o);
    return v;
}
__device__ __forceinline__ float wave_max(float v) {
#pragma unroll
    for (int o = 1; o < 64; o <<= 1) v = fmaxf(v, __shfl_xor(v, o));
    return v;
}
#define LDS_WAIT() asm volatile("s_waitcnt lgkmcnt(0)" ::: "memory")
__device__ __forceinline__ int crow(int r, int hi) { return (r & 3) + 8 * (r >> 2) + 4 * hi; }

enum { MAP_ID = 0, MAP_P32 = 1, MAP_CONV = 2 };
template <int MAP> __device__ __forceinline__ int colmap(int slot) {
    if (MAP == MAP_ID) return slot;
    if (MAP == MAP_P32) return (slot & ~31) + pg8::perm32(slot & 31);
    const int pn = slot >> 8, s = slot & 255, bj = s >> 7, wc = (s >> 5) & 3, n = (s >> 4) & 1, q = s & 15;
    return (2 * bj + n) * 4096 + 64 * pn + 16 * wc + q;
}
template <int MAP> __device__ __forceinline__ void transpose_item(const float* W, int K, int N, bf16* WT, LAS float* scr, int item, int lane) {
    const int nblk = N / 32, kb = item / nblk, nb = item % nblk, k0 = 64 * kb, n0 = 32 * nb;
    const int col = colmap<MAP>(n0 + (lane & 31));
    float tv[32];
#pragma unroll
    for (int i = 0; i < 32; ++i) { const int kk = 2 * i + (lane >> 5); tv[i] = ((const GAS float*)W)[(size_t)(k0 + kk) * N + col]; }
#pragma unroll
    for (int i = 0; i < 32; ++i) { const int kk = 2 * i + (lane >> 5); scr[kk * 33 + (lane & 31)] = tv[i]; }
    LDS_WAIT();
    const int c = lane & 7;
#pragma unroll
    for (int j = 0; j < 4; ++j) { const int n = (lane >> 3) + 8 * j; const LAS float* s = scr + (8 * c) * 33 + n;
        v4u o; o.x = pk2(s[0 * 33], s[1 * 33]); o.y = pk2(s[2 * 33], s[3 * 33]); o.z = pk2(s[4 * 33], s[5 * 33]); o.w = pk2(s[6 * 33], s[7 * 33]);
        *(GAS v4u*)(WT + (size_t)(n0 + n) * K + k0 + 8 * c) = o; }
    LDS_WAIT();
}
template <int MAP> __device__ __forceinline__ void transpose_all(const float* W, int K, int N, bf16* WT, LAS float* scr, int gw, int NGW, int lane) {
    const int items = (K / 64) * (N / 32);
    for (int it = gw; it < items; it += NGW) transpose_item<MAP>(W, K, N, WT, scr, it, lane);
}

struct Args { const float* in[38]; float* out; unsigned char* ws; int ph_lo, ph_hi; };
__device__ __forceinline__ const float* argp(int i) { const char* k = (const char*)__builtin_amdgcn_kernarg_segment_ptr(); asm volatile("" : "+s"(k)); const float* p = *(const float* const*)(k + 8 * i); return (const float*)(const GAS float*)p; }

__device__ __forceinline__ void mod_item(float* mod, LAS float* scr, int it, int lane) {
    const int l = it / 1536, r = it % 1536, kc = r / 96, cb = r % 96, k0 = kc * 128, col = cb * 64 + lane;
    const float* Wm = argp(l == 0 ? 5 : l == 1 ? 12 : l == 2 ? 24 : 32);
    const float* bm = argp(l == 0 ? 6 : l == 1 ? 13 : l == 2 ? 25 : 33);
    const float* c = argp(1); const float* cc = argp(3);
#pragma unroll
    for (int j = 0; j < 2; ++j) { const int kk = lane + 64 * j;
#pragma unroll
        for (int bi = 0; bi < 5; ++bi) { const float cv = bi < 4 ? c[bi * 2048 + k0 + kk] : cc[k0 + kk]; scr[bi * 128 + kk] = cv / (1.0f + __expf(-cv)); } }
    LDS_WAIT();
    float acc[5] = {0.f, 0.f, 0.f, 0.f, 0.f};
    const float* wp = Wm + (size_t)k0 * 6144 + col;
#pragma unroll 8
    for (int kk = 0; kk < 128; ++kk) { const float w = ((const GAS float*)wp)[(size_t)kk * 6144];
#pragma unroll
        for (int bi = 0; bi < 5; ++bi) acc[bi] += scr[bi * 128 + kk] * w; }
    if (kc == 0) { const float b = bm[col];
#pragma unroll
        for (int bi = 0; bi < 5; ++bi) acc[bi] += b; }
#pragma unroll
    for (int bi = 0; bi < 5; ++bi) atomicAdd(mod + (size_t)(l * 5 + bi) * 6144 + col, acc[bi]);
    LDS_WAIT();
}

__device__ __forceinline__ void norm_row(const float* src, const float* g, const float* md, bf16* dst, int lane, const float* slab = nullptr, const float* gate = nullptr, float* upd = nullptr) {
    const GAS f32x4* xr = (const GAS f32x4*)src + lane;
    f32x4 v[8]; float s = 0.f;
#pragma unroll
    for (int j = 0; j < 8; ++j) v[j] = xr[64 * j];
    if (slab) {
#pragma unroll
        for (int j = 0; j < 8; ++j) { f32x4 a = {0.f, 0.f, 0.f, 0.f};
#pragma unroll
            for (int ks = 0; ks < 8; ++ks) a += *((const GAS f32x4*)(slab + (size_t)ks * 1024 * 2048) + 64 * j + lane);
            v[j] += a * *((const GAS f32x4*)gate + 64 * j + lane); *((GAS f32x4*)upd + 64 * j + lane) = v[j]; }
    }
#pragma unroll
    for (int j = 0; j < 8; ++j) s += (v[j].x * v[j].x + v[j].y * v[j].y) + (v[j].z * v[j].z + v[j].w * v[j].w);
    const float rstd = 1.0f / sqrtf(wave_sum(s) * (1.0f / 2048.0f) + EPS);
#pragma unroll
    for (int j = 0; j < 8; ++j) { const int col = 256 * j + 4 * lane;
        const f32x4 g4 = *(const GAS f32x4*)(g + col), sh = *(const GAS f32x4*)(md + col), sc = *(const GAS f32x4*)(md + 2048 + col);
        const f32x4 y = (v[j] * rstd) * g4 * (sc + 1.0f) + sh;
        v2u o; o.x = pk2(y.x, y.y); o.y = pk2(y.z, y.w); *(GAS v2u*)(dst + col) = o; }
}

__device__ __forceinline__ void conv_item(const bf16* __restrict__ U, const bf16* __restrict__ BZ, bf16* __restrict__ Gd, const float* __restrict__ cw, const float* __restrict__ cb, int item, int tid) {
    const int r0 = 16 * item, col = 8 * tid;
    int s0, s1; if (r0 < ML) { s0 = r0 & ~4095; s1 = s0 + 4096; } else { s0 = ML + ((r0 - ML) & ~255); s1 = s0 + 256; }
    float w0[8], w1[8], w2[8], bb[8];
#pragma unroll
    for (int h = 0; h < 2; ++h) { const f32x4 a = *(const f32x4*)(cw + col + 4 * h), b = *(const f32x4*)(cw + 4096 + col + 4 * h), c = *(const f32x4*)(cw + 8192 + col + 4 * h), d = *(const f32x4*)(cb + col + 4 * h);
#pragma unroll
        for (int e = 0; e < 4; ++e) { w0[4 * h + e] = a[e]; w1[4 * h + e] = b[e]; w2[4 * h + e] = c[e]; bb[4 * h + e] = d[e]; } }
    const v4u zero = {0u, 0u, 0u, 0u};
    v4u prev = (r0 > s0) ? *(const GAS v4u*)(U + (size_t)(r0 - 1) * 4096 + col) : zero;
    v4u cur = *(const GAS v4u*)(U + (size_t)r0 * 4096 + col);
    for (int i4 = 0; i4 < 16; i4 += 4) {
      v4u nx[4], bzv[4];
#pragma unroll
      for (int j = 0; j < 4; ++j) { const int r = r0 + i4 + j; nx[j] = (r + 1 < s1) ? *(const GAS v4u*)(U + (size_t)(r + 1) * 4096 + col) : zero; bzv[j] = *(const GAS v4u*)(BZ + (size_t)r * 4096 + col); }
#pragma unroll
      for (int j = 0; j < 4; ++j) { const int r = r0 + i4 + j; const v4u nxt = nx[j], bz = bzv[j];
        v4u o;
#pragma unroll
        for (int w = 0; w < 4; ++w) {
            const float y0 = w0[2 * w] * bflo(prev[w]) + w1[2 * w] * bflo(cur[w]) + w2[2 * w] * bflo(nxt[w]) + bb[2 * w];
            const float y1 = w0[2 * w + 1] * bfhi(prev[w]) + w1[2 * w + 1] * bfhi(cur[w]) + w2[2 * w + 1] * bfhi(nxt[w]) + bb[2 * w + 1];
            o[w] = pk2(bflo(bz[w]) * y0, bfhi(bz[w]) * y1); }
        *(GAS v4u*)(Gd + (size_t)r * 4096 + col) = o;
        prev = cur; cur = nxt; }
    }
}

template <int HD> __device__ __forceinline__ void qknorm_item(bf16* X, int ld, int item, const v4u raw, const float* gain, float oscale, const float2* tab, int lane) {
    constexpr int LPH = HD / 8, NF = HD / 4;
    const int parts = ld / 512, row = item / parts, part = item % parts, col = (part * 64 + lane) * 8, d0 = col % HD;
    bf16* p = X + (size_t)row * ld + col;
    float v[8];
#pragma unroll
    for (int w = 0; w < 4; ++w) { v[2 * w] = bflo(raw[w]); v[2 * w + 1] = bfhi(raw[w]); }
    float ss = 0.f;
#pragma unroll
    for (int e = 0; e < 8; ++e) ss += v[e] * v[e];
#pragma unroll
    for (int o = 1; o < LPH; o <<= 1) ss += __shfl_xor(ss, o);
    const float rstd = 1.0f / sqrtf(ss * (1.0f / HD) + EPS);
#pragma unroll
    for (int e = 0; e < 8; ++e) v[e] = v[e] * rstd * gain[d0 + e];
    float pv[8];
#pragma unroll
    for (int e = 0; e < 8; ++e) pv[e] = __shfl_xor(v[e], LPH / 4);
    if (row < ML) {
        const int t = row & 4095, axis = d0 / (HD / 2), half = (d0 / NF) & 1, f0 = d0 % NF, pos = axis ? (t & 63) : (t >> 6);
        const float2* cs = tab + pos * NF + f0;
#pragma unroll
        for (int e = 0; e < 8; ++e) { const float2 c = cs[e]; v[e] = half ? (pv[e] * c.y + v[e] * c.x) : (v[e] * c.x - pv[e] * c.y); }
    }
    v4u o;
#pragma unroll
    for (int w = 0; w < 4; ++w) o[w] = pk2(v[2 * w] * oscale, v[2 * w + 1] * oscale);
    *(GAS v4u*)p = o;
}
template <int HD> __device__ __forceinline__ void qknorm_all(bf16* X, int ld, int nitems, const float* gain, float oscale, const float2* tab, int gw, int NGW, int lane) {
    const int parts = ld / 512;
    for (int it = gw * 4; it < nitems; it += NGW * 4) {
        v4u raw[4];
#pragma unroll
        for (int j = 0; j < 4; ++j) { const int item = it + j, row = item / parts, part = item % parts; raw[j] = *(const GAS v4u*)(X + (size_t)row * ld + (part * 64 + lane) * 8); }
#pragma unroll
        for (int j = 0; j < 4; ++j) qknorm_item<HD>(X, ld, it + j, raw[j], gain, oscale, tab, lane);
    }
}

__device__ __forceinline__ s16x4 vtr(const LAS unsigned char* p) { typedef short v4i16_t __attribute__((ext_vector_type(4))); return __builtin_bit_cast(s16x4, __builtin_amdgcn_ds_read_tr16_b64_v4i16((LAS v4i16_t*)p)); }
template <bool DIFF, int VAR = 0>
__device__ __forceinline__ void attn_phase(LAS unsigned char* lds, const bf16* Q, bf16* O, const bf16* K, const bf16* V, const bf16* Z, const int ldk,
                                           const float shift2, const float lam, const float* subnorm, const float* sink, const float oscale, const int G, const int vcu) {
    int tid_ = threadIdx.x; asm volatile("" : "+v"(tid_));
    const int tid = tid_, lane = tid & 63, wid = __builtin_amdgcn_readfirstlane(tid >> 6), r32 = lane & 31, hi = lane >> 5;
    constexpr int KSTR = 272, VSTR = 320, KBYTES = 64 * KSTR, STAGE = KBYTES + 64 * VSTR, XOFF = 0, WSOFF = 3 * STAGE;
    static_assert(WSOFF + 8 * 128 <= LDS_BARST && 65536 <= 3 * STAGE, "attention LDS map");
    constexpr int DSTEPS = DIFF ? 4 : 8;
    const int nunits = DIFF ? 128 * 34 : 2048;
    const int skey = tid >> 4, scc = tid & 15;
    LAS float* wsf = (LAS float*)(lds + WSOFF) + wid * 32;
    const int vrow = 4 * hi + ((lane & 15) >> 2), vcol = 16 * ((lane >> 4) & 1) + 4 * (lane & 3);
    for (int u = vcu, ui = 0; u < nunits; u += G, ++ui) {
        int nlat, lat0, ctx0, koff, myq0, qcol0, kd0, zcol0, kt0 = 0, qpos = 0, qb_ = 0; float sinkv = 0.f;
        if (DIFF) {
            int bh, qi; if (u < 4096) { bh = u >> 5; qi = u & 31; } else { bh = (u - 4096) >> 1; qi = 32 + ((u - 4096) & 1); }
            const int b = bh >> 5, h = bh & 31, m = wid >> 2, qs = wid & 3; (void)ui;
            int qrow0; if (qi < 32) { qrow0 = b * 4096 + 128 * qi; nlat = 64; } else { qrow0 = ML + b * 256 + 128 * (qi - 32); nlat = 0; }
            lat0 = b * 4096; ctx0 = ML + b * 256; koff = h * 128; myq0 = qrow0 + 32 * qs; qcol0 = h * 128 + 64 * m; kd0 = 64 * m; zcol0 = h * 128;
        } else {
            const int b = u >> 9, kvh = (u >> 6) & 7, qb = u & 63, g = wid >> 1, qs = wid & 1, head = kvh * 4 + g;
            kt0 = qb - 2 < 0 ? 0 : qb - 2; const int kt1 = qb + 2 > 63 ? 63 : qb + 2; nlat = kt1 - kt0 + 1;
            lat0 = b * 4096 + 64 * kt0; ctx0 = ML + b * 256; koff = kvh * 128; myq0 = b * 4096 + 64 * qb + 32 * qs; qcol0 = head * 128; kd0 = 0; zcol0 = head * 128;
            qpos = 64 * qb + 32 * qs + r32; sinkv = sink[head]; qb_ = qb;
        }
        const int nt = nlat + 4;
        bf16x8 qf[DSTEPS];
#pragma unroll
        for (int d = 0; d < DSTEPS; ++d) qf[d] = *(const GAS bf16x8*)(Q + (size_t)(myq0 + r32) * 4096 + qcol0 + 16 * d + 8 * hi);
        f32x16 o[4];
#pragma unroll
        for (int e = 0; e < 4; ++e)
#pragma unroll
            for (int r = 0; r < 16; ++r) o[e][r] = 0.f;
        float lsum = 0.f;
        v4u kreg[2], vreg[2];
#define ATT_TROW(tt) (((tt) < nlat) ? lat0 + 64 * (tt) : ctx0 + 64 * ((tt) - nlat))
#define ATT_LOAD(tt) do { const int r0_ = ATT_TROW(tt); _Pragma("unroll") for (int i = 0; i < 2; ++i) { const size_t go = (size_t)(r0_ + skey + 32 * i) * ldk + koff + 8 * scc; kreg[i] = *(const GAS v4u*)(K + go); vreg[i] = *(const GAS v4u*)(V + go); } } while (0)
#define ATT_WRITE(so) do { _Pragma("unroll") for (int i = 0; i < 2; ++i) { *(LAS v4u*)(lds + (so) + (skey + 32 * i) * KSTR + scc * 16) = kreg[i]; *(LAS v4u*)(lds + (so) + KBYTES + (skey + 32 * i) * VSTR + scc * 16) = vreg[i]; } } while (0)
#define ATT_QK(S0_, S1_, so) do { const LAS unsigned char* kp_ = lds + (so) + r32 * KSTR + (kd0 + 8 * hi) * 2; \
            _Pragma("unroll") for (int r = 0; r < 16; ++r) { S0_[r] = -shift2; S1_[r] = -shift2; } \
            _Pragma("unroll") for (int d = 0; d < DSTEPS; ++d) { const bf16x8 k0_ = *(const LAS bf16x8*)(kp_ + d * 32), k1_ = *(const LAS bf16x8*)(kp_ + 32 * KSTR + d * 32); \
                S0_ = __builtin_amdgcn_mfma_f32_32x32x16_bf16(k0_, qf[d], S0_, 0, 0, 0); S1_ = __builtin_amdgcn_mfma_f32_32x32x16_bf16(k1_, qf[d], S1_, 0, 0, 0); \
                } } while (0)
        ATT_LOAD(0); ATT_WRITE(0); ATT_LOAD(1); ATT_WRITE(STAGE);
        __syncthreads();
        f32x16 s0, s1, n0, n1;
        constexpr bool PIPE = DIFF;
        if (PIPE) ATT_QK(s0, s1, 0);
        int so_c = 0, so_n = STAGE, so_w = 2 * STAGE;
        for (int t = 0; t < nt; ++t) {
            if (VAR != 2) { const int tl = t + 2 < nt ? t + 2 : nt - 1; ATT_LOAD(tl); } __builtin_amdgcn_sched_barrier(0);
            if (PIPE) { const int so_q = t + 1 < nt ? so_n : so_c; ATT_QK(n0, n1, so_q); }
            else ATT_QK(s0, s1, so_c);
#pragma unroll
            for (int r = 0; r < 16; ++r) { if (VAR == 1) { s0[r] = s0[r] * 1.0001f + 0.5f; s1[r] = s1[r] * 1.0001f + 0.5f; } else { s0[r] = __builtin_amdgcn_exp2f(s0[r]); s1[r] = __builtin_amdgcn_exp2f(s1[r]); } }
            if (!DIFF && t < nlat && (kt0 + t == qb_ - 2 || kt0 + t == qb_ + 2)) { const int lim = 128; const int kb0 = 64 * (kt0 + t) - qpos;
#pragma unroll
                for (int r = 0; r < 16; ++r) { const int dd = kb0 + crow(r, hi); if (dd < -lim || dd > lim) s0[r] = 0.f; if (dd + 32 < -lim || dd + 32 > lim) s1[r] = 0.f; } }
            { float a = 0.f, b = 0.f;
#pragma unroll
              for (int r = 0; r < 16; ++r) { a += s0[r]; b += s1[r]; }
              lsum += a + b; }
            const LAS unsigned char* vp = lds + so_c + KBYTES + vrow * VSTR + vcol * 2;
#pragma unroll
            for (int kb = 0; kb < 2; ++kb)
#pragma unroll
                for (int sp = 0; sp < 2; ++sp) {
                    v4u pw;
#pragma unroll
                    for (int w = 0; w < 4; ++w) pw[w] = kb == 0 ? pk2(s0[8 * sp + 2 * w], s0[8 * sp + 2 * w + 1]) : pk2(s1[8 * sp + 2 * w], s1[8 * sp + 2 * w + 1]);
                    const bf16x8 pa = __builtin_bit_cast(bf16x8, pw);
#pragma unroll
                    for (int eb = 0; eb < 4; ++eb) {
                        const s16x4 lo = vtr(vp + (32 * kb + 16 * sp) * VSTR + 64 * eb), hh = vtr(vp + (32 * kb + 16 * sp + 8) * VSTR + 64 * eb);
                        const bf16x8 vb = (bf16x8){lo[0], lo[1], lo[2], lo[3], hh[0], hh[1], hh[2], hh[3]};
                        o[eb] = __builtin_amdgcn_mfma_f32_32x32x16_bf16(pa, vb, o[eb], 0, 0, 0); } }
            if (VAR != 2) ATT_WRITE(so_w);
            __syncthreads();
            if (PIPE) { s0 = n0; s1 = n1; }
            { const int tmp = so_c; so_c = so_n; so_n = so_w; so_w = tmp; }
        }
#undef ATT_TROW
#undef ATT_LOAD
#undef ATT_WRITE
#undef ATT_QK
        float lt = lsum + __shfl_xor(lsum, 32);
        if (!DIFF) lt += __builtin_amdgcn_exp2f(sinkv * LOG2E - shift2);
        if (hi == 0) wsf[r32] = lt;
        LDS_WAIT();
        float rl[16];
#pragma unroll
        for (int r = 0; r < 16; ++r) rl[r] = 1.0f / wsf[crow(r, hi)];
        LDS_WAIT();
        if (DIFF) {
            LAS float* X = (LAS float*)(lds + XOFF) + (wid & 3) * 4096 + lane;
            if (wid >= 4) {
#pragma unroll
                for (int eb = 0; eb < 4; ++eb)
#pragma unroll
                    for (int r = 0; r < 16; ++r) X[(eb * 16 + r) * 64] = o[eb][r] * rl[r] * lam;
            }
            __syncthreads();
            if (wid < 4) {
                float ssq[16];
#pragma unroll
                for (int r = 0; r < 16; ++r) ssq[r] = 0.f;
#pragma unroll
                for (int eb = 0; eb < 4; ++eb)
#pragma unroll
                    for (int r = 0; r < 16; ++r) { const float v = o[eb][r] * rl[r] - X[(eb * 16 + r) * 64]; o[eb][r] = v; ssq[r] += v * v; }
#pragma unroll
                for (int r = 0; r < 16; ++r) { float s = ssq[r];
#pragma unroll
                    for (int of = 1; of < 32; of <<= 1) s += __shfl_xor(s, of);
                    ssq[r] = oscale / sqrtf(s * (1.0f / 128.0f) + EPS); }
#pragma unroll
                for (int eb = 0; eb < 4; ++eb) { const float gn = subnorm[32 * eb + r32];
                    unsigned zz[16];
#pragma unroll
                    for (int r = 0; r < 16; ++r) zz[r] = (unsigned)((const GAS bf16*)Z)[(size_t)(myq0 + crow(r, hi)) * 4096 + zcol0 + 32 * eb + r32];
#pragma unroll
                    for (int r = 0; r < 16; ++r) { const size_t off = (size_t)(myq0 + crow(r, hi)) * 4096 + zcol0 + 32 * eb + r32;
                        ((GAS bf16*)O)[off] = (bf16)f2bf(o[eb][r] * ssq[r] * gn * pg8::silu_f(bflo(zz[r]))); } }
            }
            __syncthreads();
        } else {
#pragma unroll
            for (int eb = 0; eb < 4; ++eb) { unsigned zz[16];
#pragma unroll
                for (int r = 0; r < 16; ++r) zz[r] = (unsigned)((const GAS bf16*)Z)[(size_t)(myq0 + crow(r, hi)) * 4096 + zcol0 + 32 * eb + r32];
#pragma unroll
                for (int r = 0; r < 16; ++r) { const size_t off = (size_t)(myq0 + crow(r, hi)) * 4096 + zcol0 + 32 * eb + r32;
                    ((GAS bf16*)O)[off] = (bf16)f2bf(o[eb][r] * rl[r] * pg8::silu_f(bflo(zz[r]))); } }
        }
    }
}

#define RLX_AGENT __ATOMIC_RELAXED, __HIP_MEMORY_SCOPE_AGENT
#define XB_TMO      128
#define XB_XCNT(j)  (256  + 64 * (j))
#define XB_XSUB(j)  (1280 + 64 * (j))
#define XB_XGEN(j)  (2304 + 64 * (j))
#define XB_TOP      3328
#define XB_TOPGEN   3392
#define XCD_BAR_WORDS 3456
#define XB_SPIN_CAP (1u << 18)

__device__ __forceinline__ unsigned xb_ld(unsigned* p)              { return __hip_atomic_load(p, __ATOMIC_RELAXED, __HIP_MEMORY_SCOPE_AGENT); }
__device__ __forceinline__ unsigned xb_add(unsigned* p, unsigned v) { return __hip_atomic_fetch_add(p, v, __ATOMIC_RELAXED, __HIP_MEMORY_SCOPE_AGENT); }
__device__ __forceinline__ unsigned xb_xcc_id() { return (unsigned)__builtin_amdgcn_s_getreg((3 << 11) | 20) & 0xFu; }
#define XB_SPIN(cond, bar) do { unsigned _sp = 0; while (cond) { __builtin_amdgcn_s_sleep(1); \
    if ((++_sp & 255u) == 0u) { if (xb_ld(&(bar)[XB_TMO])) break; if (_sp > XB_SPIN_CAP) { atomicAdd(&(bar)[XB_TMO], 1u); break; } } } } while (0)

struct XcdBarrier {
    unsigned* bar; unsigned x;
    volatile LAS unsigned* st;
};

__device__ __forceinline__ XcdBarrier xcd_barrier_post(unsigned* bar, volatile LAS unsigned* st) {
    XcdBarrier b; b.bar = bar; b.x = xb_xcc_id(); b.st = st;
    if (threadIdx.x == 0) (void)xb_add(&bar[XB_XCNT(b.x)], 1u);
    return b;
}
__device__ __forceinline__ void xcd_barrier_complete(unsigned* bar, unsigned x, unsigned& nloc, unsigned& nx) {
    const unsigned G = gridDim.x * gridDim.y * gridDim.z;
    unsigned sum, cnt, mine, sp = 0u;
    for (;;) {
        sum = 0u; cnt = 0u; mine = 0u;
#pragma unroll
        for (unsigned j = 0; j < 16; ++j) { const unsigned c = xb_ld(&bar[XB_XCNT(j)]); sum += c; cnt += (c > 0u) ? 1u : 0u; mine = (j == x) ? c : mine; }
        if (sum == G) break;
        __builtin_amdgcn_s_sleep(1);
        if ((++sp & 255u) == 0u) { if (xb_ld(&bar[XB_TMO])) break; if (sp > XB_SPIN_CAP) { atomicAdd(&bar[XB_TMO], 1u); break; } }
    }
    nloc = mine > 0u ? mine : 1u; nx = cnt > 0u ? cnt : 1u;
}

__device__ __forceinline__ void xcd_barrier(const XcdBarrier& b) {
    asm volatile("s_waitcnt vmcnt(0)" ::: "memory");
    __syncthreads();
    if (threadIdx.x == 0) {
        unsigned* bar = b.bar;
        __builtin_amdgcn_s_waitcnt(0);
        unsigned nloc = b.st[0], nx = b.st[1];
        if (nloc == 0u) { xcd_barrier_complete(bar, b.x, nloc, nx); b.st[0] = nloc; b.st[1] = nx; }
        const unsigned old = xb_add(&bar[XB_XSUB(b.x)], 1u);
        const unsigned gen = old / nloc;
        if (old + 1u == (gen + 1u) * nloc) {
            __builtin_amdgcn_fence(__ATOMIC_RELEASE, "agent");
            asm volatile("s_waitcnt vmcnt(0)" ::: "memory");
            const unsigned og = xb_add(&bar[XB_TOP], 1u);
            const unsigned tg = og / nx;
            if (og + 1u == (tg + 1u) * nx) xb_add(&bar[XB_TOPGEN], 1u);
            else XB_SPIN(xb_ld(&bar[XB_TOPGEN]) == tg, bar);
            __builtin_amdgcn_fence(__ATOMIC_ACQUIRE, "agent");
            xb_add(&bar[XB_XGEN(b.x)], 1u);
            asm volatile("s_waitcnt vmcnt(0)" ::: "memory");
        } else {
            XB_SPIN(xb_ld(&bar[XB_XGEN(b.x)]) == gen, bar);
            __builtin_amdgcn_fence(__ATOMIC_ACQUIRE, "agent");
            asm volatile("s_waitcnt vmcnt(0)" ::: "memory");
        }
    }
    __syncthreads();
}

#ifndef G2_ALIGN
#define G2_ALIGN false
#endif
#ifndef MK_SINGLE
#define MK_SINGLE 1
#endif
__global__ void __launch_bounds__(NWAVES * 64, 2) mk_fwd(Args a) {
    extern __shared__ __attribute__((aligned(16))) unsigned char lds_raw[];
    LAS unsigned char* lds = (LAS unsigned char*)lds_raw;
    cg::grid_group grid = cg::this_grid();
    const int lo = a.ph_lo, hi = a.ph_hi;
#define PHASE_LOCALS \
    int tid_ = threadIdx.x; asm volatile("" : "+v"(tid_)); const int tid = tid_, lane = tid & 63, wave = __builtin_amdgcn_readfirstlane(tid >> 6); (void)lane; (void)wave; \
    int G_ = gridDim.x, bx_ = blockIdx.x; asm volatile("" : "+s"(G_), "+s"(bx_)); const int G = G_, bx = bx_, vcu = (G % 8 == 0) ? (bx % 8) * (G / 8) + bx / 8 : bx; \
    const int gw = vcu * NWAVES + wave, NGW = G * NWAVES; (void)gw; (void)NGW; \
    unsigned char* ws_ = a.ws; asm volatile("" : "+s"(ws_)); unsigned char* ws = (unsigned char*)(GAS unsigned char*)ws_; \
    float* mod = (float*)(ws + WS_MOD); float2* tab64 = (float2*)(ws + WS_TAB); float2* tab128 = tab64 + 64 * 16; (void)mod; (void)tab64; (void)tab128; \
    bf16* WTin = (bf16*)(ws + WS_WTIN); bf16* WTout = (bf16*)(ws + WS_WTOUT); bf16* HA = (bf16*)(ws + WS_HA); float* cbuf = (float*)(ws + WS_CBUF); (void)WTin; (void)WTout; (void)HA; (void)cbuf; \
    bf16* S0 = (bf16*)(ws + WS_SLOT); bf16* S1 = (bf16*)(ws + WS_SLOT + SLOT_BYTES); bf16* S2 = (bf16*)(ws + WS_SLOT + 2 * SLOT_BYTES); bf16* S3 = (bf16*)(ws + WS_SLOT + 3 * SLOT_BYTES); (void)S0; (void)S1; (void)S2; (void)S3; \
    LAS float* scr = (LAS float*)(lds + wave * 16384); (void)scr;
#define IN(k) (lo <= (k) && (k) < hi)
#define SEAM(k) do { if ((k) + 1 < hi) { if ((k) == 0) grid.sync(); else { unsigned char* wsb_ = a.ws; asm volatile("" : "+s"(wsb_)); XcdBarrier bar_; bar_.bar = (unsigned*)(wsb_ + WS_BAR); bar_.x = xb_xcc_id(); bar_.st = (volatile LAS unsigned*)(lds + LDS_BARST); xcd_barrier(bar_); } } } while (0)
    if (hi - lo > 1) {
        if (threadIdx.x < 2) ((volatile LAS unsigned*)(lds + LDS_BARST))[threadIdx.x] = 0u;
        __syncthreads();
        unsigned char* wsb_ = a.ws; (void)xcd_barrier_post((unsigned*)(wsb_ + WS_BAR), (volatile LAS unsigned*)(lds + LDS_BARST));
    }

    if (IN(0)) { PHASE_LOCALS
        transpose_all<MAP_CONV>(argp(7), DM, 4 * DI, WTin, scr, gw, NGW, lane);
        transpose_all<MAP_ID>(argp(10), DI, DM, WTout, scr, gw, NGW, lane);
#ifdef PROBE_DUP_TRANS
        transpose_all<MAP_CONV>(argp(7), DM, 4 * DI, WTin, scr, gw, NGW, lane);
        transpose_all<MAP_ID>(argp(10), DI, DM, WTout, scr, gw, NGW, lane);
#endif
        for (int it = gw; it < 6144; it += NGW) mod_item(mod, scr, it, lane);
        if (bx == 0) {
            for (int i = tid; i < 64 * 16; i += NWAVES * 64) { const int pos = i >> 4, f = i & 15; const float ang = (float)pos * exp2f(-(float)f * (13.287712379549449f / 16.0f)); tab64[i] = make_float2(cosf(ang), sinf(ang)); }
            for (int i = tid; i < 64 * 32; i += NWAVES * 64) { const int pos = i >> 5, f = i & 31; const float ang = (float)pos * exp2f(-(float)f * (13.287712379549449f / 32.0f)); tab128[i] = make_float2(cosf(ang), sinf(ang)); }
        }
        SEAM(0);
    }
#pragma unroll
    for (int l = 0; l < 4; ++l) {
        const int base = 1 + 5 * l, kind = (l == 3) ? 0 : l;
        const int LB = l == 0 ? 4 : l == 1 ? 11 : l == 2 ? 23 : 31, LW = l == 0 ? 10 : l == 1 ? 22 : l == 2 ? 30 : 37;
#define XCUR (l == 0 ? argp(0) : (const float*)(const GAS float*)a.out)
#define CCUR (l == 0 ? argp(2) : (const float*)cbuf)
        const int m1 = (l == 3) ? ML : MT;
        if (IN(base)) { PHASE_LOCALS
            if (l > 0) {
                if (kind == 0) transpose_all<MAP_CONV>(argp(LB + 3), DM, 4 * DI, WTin, scr, gw, NGW, lane);
                else if (kind == 1) transpose_all<MAP_P32>(argp(LB + 3), DM, 4 * DI, WTin, scr, gw, NGW, lane);
                else transpose_all<MAP_P32>(argp(LB + 3), DM, 2 * DI + 2048, WTin, scr, gw, NGW, lane);
                transpose_all<MAP_ID>(argp(LW), DI, DM, WTout, scr, gw, NGW, lane);
            }
#ifdef PROBE_DUP_TRANS
            if (l > 0) {
                if (kind == 0) transpose_all<MAP_CONV>(argp(LB + 3), DM, 4 * DI, WTin, scr, gw, NGW, lane);
                else if (kind == 1) transpose_all<MAP_P32>(argp(LB + 3), DM, 4 * DI, WTin, scr, gw, NGW, lane);
                else transpose_all<MAP_P32>(argp(LB + 3), DM, 2 * DI + 2048, WTin, scr, gw, NGW, lane);
                transpose_all<MAP_ID>(argp(LW), DI, DM, WTout, scr, gw, NGW, lane);
            }
#endif
            const float* xc = XCUR; const float* cc = CCUR; const float* ng = argp(LB);
            float* slab = (float*)(ws + WS_SLAB); (void)slab;
            for (int row = gw; row < m1; row += NGW) { const bool lat = row < ML;
                if (lat || l == 0) norm_row(lat ? xc + (size_t)row * DM : cc + (size_t)(row - ML) * DM, ng, mod + (size_t)(l * 5 + (lat ? (row >> 12) : 4)) * 6144, HA + (size_t)row * DM, lane);
                else { const float* prev = l == 1 ? argp(2) : (const float*)cbuf;
                    norm_row(prev + (size_t)(row - ML) * DM, ng, mod + (size_t)(l * 5 + 4) * 6144, HA + (size_t)row * DM, lane, slab + (size_t)(row - ML) * DM, mod + (size_t)((l - 1) * 5 + 4) * 6144 + 4096, cbuf + (size_t)(row - ML) * DM); } }
#ifdef PROBE_DUP_NORMCONV
            {
            const float* xc = XCUR; const float* cc = CCUR; const float* ng = argp(LB);
            float* slab = (float*)(ws + WS_SLAB); (void)slab;
            for (int row = gw; row < m1; row += NGW) { const bool lat = row < ML;
                if (lat || l == 0) norm_row(lat ? xc + (size_t)row * DM : cc + (size_t)(row - ML) * DM, ng, mod + (size_t)(l * 5 + (lat ? (row >> 12) : 4)) * 6144, HA + (size_t)row * DM, lane);
                else { const float* prev = l == 1 ? argp(2) : (const float*)cbuf;
                    norm_row(prev + (size_t)(row - ML) * DM, ng, mod + (size_t)(l * 5 + 4) * 6144, HA + (size_t)row * DM, lane, slab + (size_t)(row - ML) * DM, mod + (size_t)((l - 1) * 5 + 4) * 6144 + 4096, cbuf + (size_t)(row - ML) * DM); } }
            }
#endif
            SEAM(base);
        }
        if (IN(base + 1)) { PHASE_LOCALS
            if (kind == 0) { pg8::Gemm g{HA, WTin, m1, 4 * DI, DM}; pg8::StaticOrder S; S.init(m1, 4 * DI, G, bx); pg8::EpiConv E{S0, S1};

#ifndef NO_G1C
                pg8::gemm_phase<pg8::EpiConv, pg8::StaticOrder, true, true>(lds, g, S, E);
#ifdef PROBE_DUP_G1
                pg8::gemm_phase<pg8::EpiConv, pg8::StaticOrder, true, true>(lds, g, S, E);
#endif
#endif
 }
            else if (kind == 1) { pg8::Gemm g{HA, WTin, m1, 4 * DI, DM}; pg8::StaticOrder S; S.init(m1, 4 * DI, G, bx); typedef pg8::EpiSplit<1, (long)(SLOT_BYTES / 2), (long)MT> EpiS1; EpiS1 E{S0};

#if !defined(NO_G1S) && !defined(NO_G1S1)
                pg8::gemm_phase<EpiS1, pg8::StaticOrder, true, true>(lds, g, S, E);
#ifdef PROBE_DUP_G1
                pg8::gemm_phase<EpiS1, pg8::StaticOrder, true, true>(lds, g, S, E);
#endif
#endif
 }
            else { pg8::Gemm g{HA, WTin, m1, 2 * DI + 2048, DM}; pg8::StaticOrder S; S.init(m1, 2 * DI + 2048, G, bx); typedef pg8::EpiSplit<2, (long)(SLOT_BYTES / 2), (long)MT> EpiS2; EpiS2 E{S0};

#if !defined(NO_G1S) && !defined(NO_G1S2)
                pg8::gemm_phase<EpiS2, pg8::StaticOrder, true, true>(lds, g, S, E);
#ifdef PROBE_DUP_G1
                pg8::gemm_phase<EpiS2, pg8::StaticOrder, true, true>(lds, g, S, E);
#endif
#endif
 }
            SEAM(base + 1);
        }
        if (IN(base + 2)) { PHASE_LOCALS
            if (kind == 0) { for (int it = bx; it < m1 / 16; it += G) conv_item(S0, S1, S2, argp(LB + 4), argp(LB + 5), it, tid); }
#ifdef PROBE_DUP_NORMCONV
            if (kind == 0) { for (int it = bx; it < m1 / 16; it += G) conv_item(S0, S1, S2, argp(LB + 4), argp(LB + 5), it, tid); }
#endif
            else if (kind == 1) {
                qknorm_all<64>(S0, DI, MT * 8, argp(LB + 4), 0.125f * LOG2E, tab64, gw, NGW, lane);
                qknorm_all<64>(S1, DI, MT * 8, argp(LB + 5), 1.0f, tab64, gw, NGW, lane);
            } else {
                qknorm_all<128>(S0, DI, ML * 8, argp(LB + 4), 0.08838834764831845f * LOG2E, tab128, gw, NGW, lane);
                qknorm_all<128>(S1, 1024, MT * 2, argp(LB + 5), 1.0f, tab128, gw, NGW, lane);
            }
            SEAM(base + 2);
        }
        if (kind != 0 && IN(base + 3)) { PHASE_LOCALS
            if (kind == 1) {
                const float gq = wave_max(fabsf(argp(LB + 4)[lane])), gk = wave_max(fabsf(argp(LB + 5)[lane]));
                const float d1 = wave_sum(argp(LB + 6)[lane] * argp(LB + 7)[lane]), d2 = wave_sum(argp(LB + 8)[lane] * argp(LB + 9)[lane]);
                const float lam = expf(d1) - expf(d2) + LAM_INIT1;
#ifndef NO_ATTN1
#ifdef PROBE_DUP_ATTN
                attn_phase<true, PROBE_DUP_ATTN - 1>(lds, S0, (bf16*)(ws + WS_END), S1, S2, S3, DI, 8.0f * gq * gk * LOG2E, lam, argp(LB + 10), nullptr, 1.0f - LAM_INIT1, G, vcu);
#endif
                attn_phase<true>(lds, S0, S0, S1, S2, S3, DI, 8.0f * gq * gk * LOG2E, lam, argp(LB + 10), nullptr, 1.0f - LAM_INIT1, G, vcu);
#endif
            } else {
                const float gq = wave_max(fmaxf(fabsf(argp(LB + 4)[lane]), fabsf(argp(LB + 4)[lane + 64]))), gk = wave_max(fmaxf(fabsf(argp(LB + 5)[lane]), fabsf(argp(LB + 5)[lane + 64])));
#ifndef NO_ATTN2
#ifdef PROBE_DUP_WATTN
                attn_phase<false>(lds, S0, (bf16*)(ws + WS_END), S1, S1 + (size_t)MT * 1024, S3, 1024, 11.313708498984761f * gq * gk * LOG2E, 0.f, nullptr, argp(LB + 6), 1.0f, G, vcu);
#endif
                attn_phase<false>(lds, S0, S0, S1, S1 + (size_t)MT * 1024, S3, 1024, 11.313708498984761f * gq * gk * LOG2E, 0.f, nullptr, argp(LB + 6), 1.0f, G, vcu);
#endif
            }
            SEAM(base + 3);
        }
        if (IN(base + 4)) { PHASE_LOCALS
            { pg8::Gemm g{kind == 0 ? S2 : S0, WTout, ML, DM, DI}; pg8::StaticOrder S; S.init(ML, DM, G, bx);
              pg8::EpiResid E{XCUR, (float*)(GAS float*)a.out, mod + (size_t)l * 5 * 6144};
              pg8::gemm_phase<pg8::EpiResid, pg8::StaticOrder, G2_ALIGN, true>(lds, g, S, E);
#ifdef PROBE_DUP_G2L0
              if (l == 0) pg8::gemm_phase<pg8::EpiResid, pg8::StaticOrder, G2_ALIGN, true>(lds, g, S, E);
#endif
            }
            if (l < 2) {
                pg8::Gemm g{kind == 0 ? S2 : S0, WTout, MT, DM, 512, DI}; pg8::SplitOrder S{bx, G}; pg8::EpiSlab E{(float*)(ws + WS_SLAB)};
#ifndef NO_SPLIT
                pg8::gemm_phase<pg8::EpiSlab, pg8::SplitOrder, true, true>(lds, g, S, E);
#endif
            }
            SEAM(base + 4);
        }
    }
#undef IN
#undef SEAM
}

extern "C" void kernel_launch(void* const* d_in, const int* in_sizes, int n_in, void* d_out, int out_size, void* d_ws, size_t ws_size, hipStream_t stream) {
    static int grid = 0;
    if (grid == 0) {
        if (n_in != 38 || in_sizes[0] != ML * DM || out_size != ML * DM || ws_size < WS_END) { fprintf(stderr, "kernel_launch: unexpected shapes (n_in %d, out %d, ws %zu < %zu)\n", n_in, out_size, ws_size, (size_t)WS_END); grid = -1; return; }
        int dev = 0, cus = 0, per_cu = 0;
        if (hipGetDevice(&dev) != hipSuccess || hipDeviceGetAttribute(&cus, hipDeviceAttributeMultiprocessorCount, dev) != hipSuccess) { grid = -1; return; }
        if (hipFuncSetAttribute((const void*)mk_fwd, hipFuncAttributeMaxDynamicSharedMemorySize, LDS_BYTES) != hipSuccess) { fprintf(stderr, "kernel_launch: hipFuncSetAttribute failed\n"); grid = -1; return; }
        if (hipOccupancyMaxActiveBlocksPerMultiprocessor(&per_cu, (const void*)mk_fwd, NWAVES * 64, LDS_BYTES) != hipSuccess || per_cu < 1) { fprintf(stderr, "kernel_launch: occupancy query says %d\n", per_cu); per_cu = 1; }
        (void)hipGetLastError();
        grid = cus;
    }
    if (grid < 0) return;
    (void)hipMemsetAsync((char*)d_ws + WS_MOD, 0, MOD_ZERO_BYTES, stream);
    Args a{};
    for (int i = 0; i < 38; ++i) a.in[i] = (const float*)d_in[i];
    a.out = (float*)d_out; a.ws = (unsigned char*)d_ws;
#if MK_SINGLE
    a.ph_lo = 0; a.ph_hi = NPH;
    void* params[] = {&a};
    const hipError_t e = hipLaunchCooperativeKernel((const void*)mk_fwd, dim3(grid), dim3(NWAVES * 64), params, LDS_BYTES, stream);
    if (e != hipSuccess) fprintf(stderr, "kernel_launch: cooperative launch failed: %s (grid %d)\n", hipGetErrorString(e), grid);
#else
    for (int ph = 0; ph < NPH; ++ph) {
        if (ph == 4 || ph == 19) continue;
        a.ph_lo = ph; a.ph_hi = ph + 1;
        hipLaunchKernelGGL(mk_fwd, dim3(grid), dim3(NWAVES * 64), LDS_BYTES, stream, a);
    }
#endif
}
```

```cpp
#include <hip/hip_runtime.h>
#include <hip/hip_cooperative_groups.h>
#include <cstdio>
#include <cstdint>
#define MK_SINGLE 1
namespace pg8 {
#define PG8_LAS __attribute__((address_space(3)))
typedef unsigned short bf16_t;
typedef short bf16x8 __attribute__((ext_vector_type(8)));
typedef float f32x4 __attribute__((ext_vector_type(4)));
typedef unsigned u32x4 __attribute__((ext_vector_type(4)));
constexpr int BM = 256, BK = 64, HALF = 128, HTB = HALF * BK * 2  , STAGE_BYTES = 8 * HTB, NXCD = 8, WGM = 8;

__host__ __device__ __forceinline__ int lds_byte(int r, int c) { const int st = (r >> 4) * 2 + (c >> 5), rr = r & 15, cc = c & 31, ob = rr * 64 + cc * 2; return st * 1024 + (ob ^ (((ob >> 9) & 1) << 5)); }
__host__ __device__ __forceinline__ void stage_rc(int b, int& R, int& C) { const int st = b / 1024, sb = b % 1024, swz = sb ^ (((sb >> 9) & 1) << 5); R = (st >> 1) * 16 + swz / 64; C = (st & 1) * 32 + (swz % 64) / 2; }
__host__ __device__ __forceinline__ int perm32(int rho) { const int n = rho >> 4, i = rho & 15; return 8 * (i >> 2) + 4 * n + (i & 3); }

struct Unit { int pm, pn, ko; };
struct Gemm { const bf16_t* A; const bf16_t* Bt; int M, N, K; int ld = 0; };

struct StaticOrder {
    int nM, nN, nwg, G, c;
    __host__ __device__ void init(int M, int N, int G_, int c_) { nM = M / BM; nN = N / BM; nwg = nM * nN; G = G_; c = c_; }
    __host__ __device__ bool next(int i, Unit& u) const {
        const long L = (long)i * G + c; if (L >= nwg) return false;
        int wgid = (int)L; { const int q = nwg / NXCD, r = nwg % NXCD, xcd = wgid % NXCD, off = wgid / NXCD; wgid = (xcd < r ? xcd * (q + 1) : r * (q + 1) + (xcd - r) * q) + off; }
        const int nig = WGM * nN, gid = wgid / nig, fm = gid * WGM, gsz = (nM - fm) < WGM ? (nM - fm) : WGM;
        u.pm = fm + ((wgid % nig) % gsz); u.pn = (wgid % nig) / gsz; u.ko = 0; return true;
    }
    __device__ __forceinline__ void a_ready(const Unit&) const {}
    __device__ __forceinline__ void done(const Unit&) const {}
};
struct SplitOrder {
    int c, G;
    __host__ __device__ bool next(int i, Unit& u) const { const int L = i * G + c; if (L >= 256) return false; u.pm = 64 + (L >> 6); u.pn = (L >> 3) & 7; u.ko = (L & 7) * 512; return true; }
    __device__ __forceinline__ void a_ready(const Unit&) const {}
    __device__ __forceinline__ void done(const Unit&) const {}
};
__device__ __forceinline__ unsigned cvt_pk_bf16(float lo, float hi) { unsigned r; asm volatile("v_cvt_pk_bf16_f32 %0, %1, %2" : "=v"(r) : "v"(lo), "v"(hi)); return r; }
typedef float f32x2 __attribute__((ext_vector_type(2)));
typedef unsigned u32x2 __attribute__((ext_vector_type(2)));
#define PG8_GAS __attribute__((address_space(1)))
__device__ __forceinline__ float silu_f(float z) { return z * __builtin_amdgcn_rcpf(1.0f + __builtin_amdgcn_exp2f(-1.4426950408889634f * z)); }

template <int KIND, long SLOT, long MROWS> struct EpiSplit {
    static constexpr bool PERM = false, AFTER_DRAIN = false;
    bf16_t* base;
    __device__ __forceinline__ void operator()(const f32x4 (&acc)[2][2][4][2], const Unit& u, int wr, int wc, int fr, int fq) const {
        const int pn = u.pn; long boff; int ld, tt;
        if (KIND == 1) { const int s = pn >> 4; boff = (long)s * SLOT; ld = 4096; tt = s << 4; }
        else { if (pn < 16) { boff = 0; ld = 4096; tt = 0; } else if (pn < 20) { boff = SLOT; ld = 1024; tt = 16; } else if (pn < 24) { boff = SLOT + MROWS * 1024; ld = 1024; tt = 20; } else { boff = 3 * SLOT; ld = 4096; tt = 24; } }
        const int row0 = u.pm * BM + wr * 64 + fr, col0 = (pn - tt) * BM + wc * 32 + 8 * fq;
        bf16_t* B = base + boff + (size_t)row0 * ld + col0;
#pragma unroll
        for (int ai = 0; ai < 2; ++ai)
#pragma unroll
            for (int m = 0; m < 4; ++m) { bf16_t* rowp = B + (size_t)((ai * HALF + m * 16) * ld);
#pragma unroll
                for (int bj = 0; bj < 2; ++bj) { const f32x4 v0 = acc[ai][bj][m][0], v1 = acc[ai][bj][m][1];
                    u32x4 w; w.x = cvt_pk_bf16(v0[0], v0[1]); w.y = cvt_pk_bf16(v0[2], v0[3]); w.z = cvt_pk_bf16(v1[0], v1[1]); w.w = cvt_pk_bf16(v1[2], v1[3]);
                    *(PG8_GAS u32x4*)(rowp + bj * HALF) = w; } }
    }
};
struct EpiConv {
    static constexpr bool PERM = false, AFTER_DRAIN = false;
    bf16_t* U; bf16_t* BZ;
    __device__ __forceinline__ void operator()(const f32x4 (&acc)[2][2][4][2], const Unit& u, int wr, int wc, int fr, int fq) const {
        const int row0 = u.pm * BM + wr * 64 + fr, col0 = u.pn * 64 + wc * 16 + 4 * fq;
#pragma unroll
        for (int ai = 0; ai < 2; ++ai)
#pragma unroll
            for (int m = 0; m < 4; ++m) { const size_t off = (size_t)(row0 + ai * HALF + m * 16) * 4096 + col0;
                const f32x4 bg = acc[ai][0][m][0], cg = acc[ai][0][m][1], xt = acc[ai][1][m][0], z = acc[ai][1][m][1];
                const f32x4 uu = cg * xt; f32x4 bz; bz[0] = bg[0] * silu_f(z[0]); bz[1] = bg[1] * silu_f(z[1]); bz[2] = bg[2] * silu_f(z[2]); bz[3] = bg[3] * silu_f(z[3]);
                u32x2 a; a.x = cvt_pk_bf16(uu[0], uu[1]); a.y = cvt_pk_bf16(uu[2], uu[3]); *(PG8_GAS u32x2*)(U + off) = a;
                u32x2 b; b.x = cvt_pk_bf16(bz[0], bz[1]); b.y = cvt_pk_bf16(bz[2], bz[3]); *(PG8_GAS u32x2*)(BZ + off) = b; }
    }
};
struct EpiResid {
    static constexpr bool PERM = false, AFTER_DRAIN = false;
    const float* xin; float* xout; const float* mod;
    __device__ __forceinline__ void operator()(const f32x4 (&acc)[2][2][4][2], const Unit& u, int wr, int wc, int fr, int fq) const {
        const float* src = xin + (size_t)u.pm * BM * 2048; float* dst = xout + (size_t)u.pm * BM * 2048;
        const float* gate = mod + (u.pm >> 4) * 6144 + 4096;
        const int rl = wr * 64 + fr, col0 = u.pn * BM + wc * 32 + 4 * fq;
        f32x4 gv[2][2];
#pragma unroll
        for (int bj = 0; bj < 2; ++bj)
#pragma unroll
            for (int n = 0; n < 2; ++n) gv[bj][n] = *(const PG8_GAS f32x4*)(gate + col0 + bj * HALF + n * 16);
#pragma unroll
        for (int ai = 0; ai < 2; ++ai)
#pragma unroll
            for (int mp = 0; mp < 2; ++mp) { f32x4 xs[2][2][2];
#pragma unroll
                for (int mm = 0; mm < 2; ++mm) { const size_t off = (size_t)(rl + ai * HALF + (2 * mp + mm) * 16) * 2048 + col0;
#pragma unroll
                    for (int bj = 0; bj < 2; ++bj)
#pragma unroll
                        for (int n = 0; n < 2; ++n) xs[mm][bj][n] = *(const PG8_GAS f32x4*)(src + off + bj * HALF + n * 16); }
#pragma unroll
                for (int mm = 0; mm < 2; ++mm) { const size_t off = (size_t)(rl + ai * HALF + (2 * mp + mm) * 16) * 2048 + col0;
#pragma unroll
                    for (int bj = 0; bj < 2; ++bj)
#pragma unroll
                        for (int n = 0; n < 2; ++n) *(PG8_GAS f32x4*)(dst + off + bj * HALF + n * 16) = xs[mm][bj][n] + gv[bj][n] * acc[ai][bj][2 * mp + mm][n]; }
                asm volatile("" ::: "memory"); }
    }
};
struct EpiSlab {
    static constexpr bool PERM = false, AFTER_DRAIN = false;
    float* slab;
    __device__ __forceinline__ void operator()(const f32x4 (&acc)[2][2][4][2], const Unit& u, int wr, int wc, int fr, int fq) const {
        float* dst = slab + ((size_t)(u.ko >> 9) * 1024 + (size_t)(u.pm - 64) * BM) * 2048;
        const int rl = wr * 64 + fr, col0 = u.pn * BM + wc * 32 + 4 * fq;
#pragma unroll
        for (int ai = 0; ai < 2; ++ai)
#pragma unroll
            for (int m = 0; m < 4; ++m) { const size_t off = (size_t)(rl + ai * HALF + m * 16) * 2048 + col0;
#pragma unroll
                for (int bj = 0; bj < 2; ++bj)
#pragma unroll
                    for (int n = 0; n < 2; ++n) *(PG8_GAS f32x4*)(dst + off + bj * HALF + n * 16) = acc[ai][bj][m][n]; }
    }
};
template <class Epi, class Sched, bool ALIGN_EPI = false, bool SP2 = false>
__device__ __forceinline__ void gemm_phase(PG8_LAS unsigned char* lds, const Gemm g, const Sched& S, const Epi& E) {
    int tid_ = threadIdx.x; asm volatile("" : "+v"(tid_));
    const int tid = tid_, wid = __builtin_amdgcn_readfirstlane(tid >> 6), lane = tid & 63, wr = wid >> 2, wc = wid & 3, fr = lane & 15, fq = lane >> 4;
    const int K = g.K, nt = K / BK, LD = g.ld ? g.ld : g.K;
    unsigned voffA[2], voffB[2];
#pragma unroll
    for (int i = 0; i < 2; ++i) { int R, C; stage_rc(tid * 16 + i * 8192, R, C); const int Rb = Epi::PERM ? ((R & ~31) + perm32(R & 31)) : R;
        voffA[i] = (unsigned)(R * LD + C) * 2u; voffB[i] = (unsigned)(Rb * LD + C) * 2u; }
    const size_t kstep = (size_t)(BK * 2);
    const size_t hstep = (size_t)HALF * LD * 2;
    const size_t tstep = 2 * hstep;
    const unsigned ldsw = (unsigned)wid * 1024u;
    const int aoff = lds_byte(wr * 64 + fr, fq * 8), boff = lds_byte(wc * 32 + fr, fq * 8);
#define PG8_SA(b, h) (((b) * 2 + (h)) * HTB)
#define PG8_SB(b, h) ((4 + (b) * 2 + (h)) * HTB)
#define PG8_STAGE(bufoff, gbase, voff) do { _Pragma("unroll") for (int _i = 0; _i < 2; ++_i) \
        __builtin_amdgcn_global_load_lds((const unsigned*)((const char*)(gbase) + (voff)[_i]), (PG8_LAS unsigned*)(lds + (bufoff) + ldsw + _i * 8192), 16, 0, 0); } while (0)
#define PG8_LDA(dst, b, h) do { _Pragma("unroll") for (int m = 0; m < 4; ++m) _Pragma("unroll") for (int k = 0; k < 2; ++k) dst[m][k] = *(const PG8_LAS bf16x8*)(lds + PG8_SA(b, h) + aoff + m * 2048 + k * 1024); } while (0)
#define PG8_LDB(dst, b, h) do { _Pragma("unroll") for (int n = 0; n < 2; ++n) _Pragma("unroll") for (int k = 0; k < 2; ++k) dst[n][k] = *(const PG8_LAS bf16x8*)(lds + PG8_SB(b, h) + boff + n * 2048 + k * 1024); } while (0)
#define PG8_MMA(ai, bj, At, Bt) do { __builtin_amdgcn_s_setprio(1); _Pragma("unroll") for (int m = 0; m < 4; ++m) _Pragma("unroll") for (int n = 0; n < 2; ++n) _Pragma("unroll") for (int k = 0; k < 2; ++k) \
        acc[ai][bj][m][n] = __builtin_amdgcn_mfma_f32_16x16x32_bf16(Bt[n][k], At[m][k], acc[ai][bj][m][n], 0, 0, 0); __builtin_amdgcn_s_setprio(0); } while (0)
#define PG8_WAIT_V(n) asm volatile("s_waitcnt vmcnt(" #n ")" ::: "memory")
#define PG8_WAIT_L(n) asm volatile("s_waitcnt lgkmcnt(" #n ")" ::: "memory")
#define PG8_BAR __builtin_amdgcn_s_barrier()
#define PG8_SCHED __builtin_amdgcn_sched_barrier(0)
    Unit cur, nxt; int ui = 0;
    if (!S.next(0, cur)) return;
    f32x4 acc[2][2][4][2];
#pragma unroll
    for (int a = 0; a < 2; ++a)
#pragma unroll
        for (int b = 0; b < 2; ++b)
#pragma unroll
            for (int m = 0; m < 4; ++m)
#pragma unroll
                for (int n = 0; n < 2; ++n) acc[a][b][m][n] = (f32x4){0.f, 0.f, 0.f, 0.f};
    bf16x8 At[4][2], B0[2][2], B1[2][2];
    const char* cA = (const char*)g.A + (size_t)cur.pm * tstep + (size_t)cur.ko * 2; const char* cB = (const char*)g.Bt + (size_t)cur.pn * tstep + (size_t)cur.ko * 2;
    S.a_ready(cur);
    if constexpr (SP2) {
        PG8_STAGE(PG8_SB(0, 0), cB, voffB); PG8_STAGE(PG8_SB(0, 1), cB + hstep, voffB); PG8_STAGE(PG8_SA(0, 0), cA, voffA); PG8_STAGE(PG8_SA(0, 1), cA + hstep, voffA);
        if (wr == 1) PG8_BAR;
        PG8_WAIT_V(2); PG8_BAR;
        PG8_STAGE(PG8_SB(1, 0), cB + kstep, voffB); PG8_STAGE(PG8_SA(1, 0), cA + kstep, voffA); PG8_STAGE(PG8_SB(1, 1), cB + hstep + kstep, voffB);
        PG8_WAIT_V(6); PG8_BAR;
    } else {
        PG8_STAGE(PG8_SB(0, 0), cB, voffB); PG8_STAGE(PG8_SA(0, 0), cA, voffA); PG8_STAGE(PG8_SB(0, 1), cB + hstep, voffB); PG8_STAGE(PG8_SA(0, 1), cA + hstep, voffA);
        if (wr == 1) PG8_BAR;
        PG8_WAIT_V(4); PG8_BAR;
        PG8_STAGE(PG8_SB(1, 0), cB + kstep, voffB); PG8_STAGE(PG8_SA(1, 0), cA + kstep, voffA); PG8_STAGE(PG8_SB(1, 1), cB + hstep + kstep, voffB);
        PG8_WAIT_V(6); PG8_BAR;
    }
    for (;;) {
        const bool has_next = S.next(ui + 1, nxt);
        const char* nA = has_next ? (const char*)g.A + (size_t)nxt.pm * tstep + (size_t)nxt.ko * 2 : cA; const char* nB = has_next ? (const char*)g.Bt + (size_t)nxt.pn * tstep + (size_t)nxt.ko * 2 : cB;
        for (int t = 0; t < nt; t += 2) {
            const bool last = (t == nt - 2);
            const char* a1 = cA + (size_t)(t + 1) * kstep;
            const char* a2 = last ? nA : cA + (size_t)(t + 2) * kstep; const char* b2 = last ? nB : cB + (size_t)(t + 2) * kstep;
            const char* a3 = a2 + kstep; const char* b3 = b2 + kstep;
            if (last && has_next) S.a_ready(nxt);
            if constexpr (SP2) {
            PG8_LDB(B0, 0, 0); PG8_LDB(B1, 0, 1); PG8_SCHED; PG8_LDA(At, 0, 0); PG8_STAGE(PG8_SA(1, 1), a1 + hstep, voffA);
            PG8_WAIT_V(8); PG8_WAIT_L(0); PG8_BAR; PG8_MMA(0, 0, At, B0); PG8_MMA(0, 1, At, B1); PG8_BAR; PG8_SCHED;
            PG8_LDA(At, 0, 1); PG8_STAGE(PG8_SB(0, 0), b2, voffB); PG8_STAGE(PG8_SB(0, 1), b2 + hstep, voffB); PG8_STAGE(PG8_SA(0, 0), a2, voffA);
            PG8_WAIT_V(8); PG8_WAIT_L(0); PG8_BAR; PG8_MMA(1, 0, At, B0); PG8_MMA(1, 1, At, B1); PG8_BAR; PG8_SCHED;
            PG8_LDB(B0, 1, 0); PG8_LDB(B1, 1, 1); PG8_SCHED; PG8_LDA(At, 1, 0); PG8_STAGE(PG8_SA(0, 1), a2 + hstep, voffA);
            PG8_WAIT_V(8); PG8_WAIT_L(0); PG8_BAR; PG8_MMA(0, 0, At, B0); PG8_MMA(0, 1, At, B1); PG8_BAR; PG8_SCHED;
            PG8_LDA(At, 1, 1); PG8_STAGE(PG8_SB(1, 0), b3, voffB); PG8_STAGE(PG8_SB(1, 1), b3 + hstep, voffB); PG8_STAGE(PG8_SA(1, 0), a3, voffA);
            PG8_WAIT_V(8); PG8_WAIT_L(0); PG8_BAR; PG8_MMA(1, 0, At, B0); PG8_MMA(1, 1, At, B1); PG8_BAR; PG8_SCHED;
            } else {
            PG8_LDB(B0, 0, 0); PG8_SCHED; PG8_LDA(At, 0, 0); PG8_STAGE(PG8_SA(1, 1), a1 + hstep, voffA);
            PG8_WAIT_L(8); PG8_BAR; PG8_WAIT_L(0); PG8_MMA(0, 0, At, B0); PG8_BAR; PG8_SCHED;
            PG8_LDB(B1, 0, 1); PG8_STAGE(PG8_SB(0, 0), b2, voffB);
            PG8_BAR; PG8_WAIT_L(0); PG8_MMA(0, 1, At, B1); PG8_BAR;
            PG8_LDA(At, 0, 1); PG8_STAGE(PG8_SA(0, 0), a2, voffA);
            PG8_BAR; PG8_WAIT_L(0); PG8_MMA(1, 0, At, B0); PG8_BAR; PG8_SCHED;
            PG8_STAGE(PG8_SB(0, 1), b2 + hstep, voffB);
            PG8_WAIT_V(6); PG8_BAR; PG8_MMA(1, 1, At, B1); PG8_BAR;
            PG8_LDB(B0, 1, 0); PG8_SCHED; PG8_LDA(At, 1, 0); PG8_STAGE(PG8_SA(0, 1), a2 + hstep, voffA);
            PG8_WAIT_L(8); PG8_BAR; PG8_WAIT_L(0); PG8_MMA(0, 0, At, B0); PG8_BAR; PG8_SCHED;
            PG8_LDB(B1, 1, 1); PG8_STAGE(PG8_SB(1, 0), b3, voffB);
            PG8_BAR; PG8_WAIT_L(0); PG8_MMA(0, 1, At, B1); PG8_BAR;
            PG8_LDA(At, 1, 1); PG8_STAGE(PG8_SA(1, 0), a3, voffA);
            PG8_BAR; PG8_WAIT_L(0); PG8_MMA(1, 0, At, B0); PG8_BAR; PG8_SCHED;
            PG8_STAGE(PG8_SB(1, 1), b3 + hstep, voffB);
            PG8_WAIT_V(6); PG8_BAR; PG8_MMA(1, 1, At, B1); PG8_BAR;
            }
        }
        if constexpr (ALIGN_EPI) { if (wr == 0) PG8_BAR; }
        if constexpr (!Epi::AFTER_DRAIN) { E(acc, cur, wr, wc, fr, fq); S.done(cur); }
        if (!has_next) break;
#pragma unroll
        for (int a = 0; a < 2; ++a)
#pragma unroll
            for (int b = 0; b < 2; ++b)
#pragma unroll
                for (int m = 0; m < 4; ++m)
#pragma unroll
                    for (int n = 0; n < 2; ++n) acc[a][b][m][n] = (f32x4){0.f, 0.f, 0.f, 0.f};
        cur = nxt; cA = nA; cB = nB; ++ui;
        if constexpr (ALIGN_EPI) { if (wr == 1) PG8_BAR; }
    }
    PG8_WAIT_V(0);
    if constexpr (!ALIGN_EPI) { if (wr == 0) PG8_BAR; }
    PG8_BAR;
    if constexpr (Epi::AFTER_DRAIN) { E.fused(acc, cur, wr, wc, fr, fq, lds, wid, lane); S.done(cur); }
#undef PG8_SA
#undef PG8_SB
#undef PG8_STAGE
#undef PG8_LDA
#undef PG8_LDB
#undef PG8_MMA
#undef PG8_WAIT_V
#undef PG8_WAIT_L
#undef PG8_BAR
#undef PG8_SCHED
}
}
namespace cg = cooperative_groups;
#define LAS __attribute__((address_space(3)))
#define GAS __attribute__((address_space(1)))
typedef unsigned short bf16;
typedef unsigned v4u __attribute__((ext_vector_type(4)));
typedef unsigned v2u __attribute__((ext_vector_type(2)));
typedef float f32x4 __attribute__((ext_vector_type(4)));
typedef float f32x16 __attribute__((ext_vector_type(16)));
typedef short bf16x8 __attribute__((ext_vector_type(8)));
typedef short s16x4 __attribute__((ext_vector_type(4)));
typedef float f32x2_t __attribute__((ext_vector_type(2)));
typedef __bf16 bf16x2_t __attribute__((ext_vector_type(2)));

constexpr int DM = 2048, DI = 4096, SEQ = 4096, ML = 16384, MC = 1024, MT = ML + MC;
constexpr float EPS = 1e-6f, LOG2E = 1.4426950408889634f;
constexpr float LAM_INIT1 = 0.35550906f;
constexpr int NWAVES = 8, NPH = 21;
constexpr int LDS_BYTES = 147456, LDS_BARST = LDS_BYTES - 64;

constexpr size_t MiB = 1u << 20;
constexpr size_t WS_MOD = 0, MOD_ZERO_BYTES = 512 * 1024;
constexpr size_t WS_BAR = 496 * 1024;
constexpr size_t WS_TAB = 1 * MiB;
constexpr size_t WS_WTIN = 2 * MiB, WS_WTOUT = 66 * MiB;
constexpr size_t WS_HA = 82 * MiB;
constexpr size_t WS_CBUF = 150 * MiB;
constexpr size_t WS_SLOT = 160 * MiB, SLOT_BYTES = 136 * MiB;
constexpr size_t WS_SLAB = WS_SLOT + 4 * SLOT_BYTES;
constexpr size_t WS_END = WS_SLAB + 64 * MiB;

__device__ __forceinline__ unsigned f2bf(float f) { unsigned u = __builtin_bit_cast(unsigned, f); return (u + 0x7fffu + ((u >> 16) & 1u)) >> 16; }
__device__ __forceinline__ unsigned pk2(float lo, float hi) { f32x2_t v = {lo, hi}; bf16x2_t b = __builtin_convertvector(v, bf16x2_t); return __builtin_bit_cast(unsigned, b); }
__device__ __forceinline__ float bflo(unsigned w) { return __builtin_bit_cast(float, w << 16); }
__device__ __forceinline__ float bfhi(unsigned w) { return __builtin_bit_cast(float, w & 0xffff0000u); }
__device__ __forceinline__ float wave_sum(float v) {
#pragma unroll
    for (int o = 1; o < 64; o <<= 1) v += __shfl_xor(v, o);
    return v;
}
__device__ __forceinline__ float wave_max(float v) {
#pragma unroll
    for (int o = 1; o < 64; o <<= 1) v = fmaxf(v, __shfl_xor(v, o));
    return v;
}
#define LDS_WAIT() asm volatile("s_waitcnt lgkmcnt(0)" ::: "memory")
__device__ __forceinline__ int crow(int r, int hi) { return (r & 3) + 8 * (r >> 2) + 4 * hi; }

enum { MAP_ID = 0, MAP_P32 = 1, MAP_CONV = 2 };
template <int MAP> __device__ __forceinline__ int colmap(int slot) {
    if (MAP == MAP_ID) return slot;
    if (MAP == MAP_P32) return (slot & ~31) + pg8::perm32(slot & 31);
    const int pn = slot >> 8, s = slot & 255, bj = s >> 7, wc = (s >> 5) & 3, n = (s >> 4) & 1, q = s & 15;
    return (2 * bj + n) * 4096 + 64 * pn + 16 * wc + q;
}
template <int MAP> __device__ __forceinline__ void transpose_item(const float* W, int K, int N, bf16* WT, LAS float* scr, int item, int lane) {
    const int nblk = N / 32, kb = item / nblk, nb = item % nblk, k0 = 64 * kb, n0 = 32 * nb;
    const int col = colmap<MAP>(n0 + (lane & 31));
    float tv[32];
#pragma unroll
    for (int i = 0; i < 32; ++i) { const int kk = 2 * i + (lane >> 5); tv[i] = ((const GAS float*)W)[(size_t)(k0 + kk) * N + col]; }
#pragma unroll
    for (int i = 0; i < 32; ++i) { const int kk = 2 * i + (lane >> 5); scr[kk * 33 + (lane & 31)] = tv[i]; }
    LDS_WAIT();
    const int c = lane & 7;
#pragma unroll
    for (int j = 0; j < 4; ++j) { const int n = (lane >> 3) + 8 * j; const LAS float* s = scr + (8 * c) * 33 + n;
        v4u o; o.x = pk2(s[0 * 33], s[1 * 33]); o.y = pk2(s[2 * 33], s[3 * 33]); o.z = pk2(s[4 * 33], s[5 * 33]); o.w = pk2(s[6 * 33], s[7 * 33]);
        *(GAS v4u*)(WT + (size_t)(n0 + n) * K + k0 + 8 * c) = o; }
    LDS_WAIT();
}
template <int MAP> __device__ __forceinline__ void transpose_all(const float* W, int K, int N, bf16* WT, LAS float* scr, int gw, int NGW, int lane) {
    const int items = (K / 64) * (N / 32);
    for (int it = gw; it < items; it += NGW) transpose_item<MAP>(W, K, N, WT, scr, it, lane);
}

struct Args { const float* in[38]; float* out; unsigned char* ws; int ph_lo, ph_hi; };
__device__ __forceinline__ const float* argp(int i) { const char* k = (const char*)__builtin_amdgcn_kernarg_segment_ptr(); asm volatile("" : "+s"(k)); const float* p = *(const float* const*)(k + 8 * i); return (const float*)(const GAS float*)p; }

__device__ __forceinline__ void mod_item(float* mod, LAS float* scr, int it, int lane) {
    const int l = it / 1536, r = it % 1536, kc = r / 96, cb = r % 96, k0 = kc * 128, col = cb * 64 + lane;
    const float* Wm = argp(l == 0 ? 5 : l == 1 ? 12 : l == 2 ? 24 : 32);
    const float* bm = argp(l == 0 ? 6 : l == 1 ? 13 : l == 2 ? 25 : 33);
    const float* c = argp(1); const float* cc = argp(3);
#pragma unroll
    for (int j = 0; j < 2; ++j) { const int kk = lane + 64 * j;
#pragma unroll
        for (int bi = 0; bi < 5; ++bi) { const float cv = bi < 4 ? c[bi * 2048 + k0 + kk] : cc[k0 + kk]; scr[bi * 128 + kk] = cv / (1.0f + __expf(-cv)); } }
    LDS_WAIT();
    float acc[5] = {0.f, 0.f, 0.f, 0.f, 0.f};
    const float* wp = Wm + (size_t)k0 * 6144 + col;
#pragma unroll 32
    for (int kk = 0; kk < 128; ++kk) { const float w = ((const GAS float*)wp)[(size_t)kk * 6144];
#pragma unroll
        for (int bi = 0; bi < 5; ++bi) acc[bi] += scr[bi * 128 + kk] * w; }
    if (kc == 0) { const float b = bm[col];
#pragma unroll
        for (int bi = 0; bi < 5; ++bi) acc[bi] += b; }
#pragma unroll
    for (int bi = 0; bi < 5; ++bi) atomicAdd(mod + (size_t)(l * 5 + bi) * 6144 + col, acc[bi]);
    LDS_WAIT();
}

__device__ __forceinline__ void norm_row(const float* src, const float* g, const float* md, bf16* dst, int lane, const float* slab = nullptr, const float* gate = nullptr, float* upd = nullptr) {
    const GAS f32x4* xr = (const GAS f32x4*)src + lane;
    f32x4 v[8]; float s = 0.f;
#pragma unroll
    for (int j = 0; j < 8; ++j) v[j] = xr[64 * j];
    if (slab) {
#pragma unroll
        for (int j = 0; j < 8; ++j) { f32x4 a = {0.f, 0.f, 0.f, 0.f};
#pragma unroll
            for (int ks = 0; ks < 8; ++ks) a += *((const GAS f32x4*)(slab + (size_t)ks * 1024 * 2048) + 64 * j + lane);
            v[j] += a * *((const GAS f32x4*)gate + 64 * j + lane); *((GAS f32x4*)upd + 64 * j + lane) = v[j]; }
    }
#pragma unroll
    for (int j = 0; j < 8; ++j) s += (v[j].x * v[j].x + v[j].y * v[j].y) + (v[j].z * v[j].z + v[j].w * v[j].w);
    const float rstd = 1.0f / sqrtf(wave_sum(s) * (1.0f / 2048.0f) + EPS);
#pragma unroll
    for (int j = 0; j < 8; ++j) { const int col = 256 * j + 4 * lane;
        const f32x4 g4 = *(const GAS f32x4*)(g + col), sh = *(const GAS f32x4*)(md + col), sc = *(const GAS f32x4*)(md + 2048 + col);
        const f32x4 y = (v[j] * rstd) * g4 * (sc + 1.0f) + sh;
        v2u o; o.x = pk2(y.x, y.y); o.y = pk2(y.z, y.w); *(GAS v2u*)(dst + col) = o; }
}

__device__ __forceinline__ void conv_item(const bf16* U, const bf16* BZ, bf16* Gd, const float* cw, const float* cb, int item, int tid) {
    const int r0 = 16 * item, col = 8 * tid;
    int s0, s1; if (r0 < ML) { s0 = r0 & ~4095; s1 = s0 + 4096; } else { s0 = ML + ((r0 - ML) & ~255); s1 = s0 + 256; }
    float w0[8], w1[8], w2[8], bb[8];
#pragma unroll
    for (int h = 0; h < 2; ++h) { const f32x4 a = *(const f32x4*)(cw + col + 4 * h), b = *(const f32x4*)(cw + 4096 + col + 4 * h), c = *(const f32x4*)(cw + 8192 + col + 4 * h), d = *(const f32x4*)(cb + col + 4 * h);
#pragma unroll
        for (int e = 0; e < 4; ++e) { w0[4 * h + e] = a[e]; w1[4 * h + e] = b[e]; w2[4 * h + e] = c[e]; bb[4 * h + e] = d[e]; } }
    const v4u zero = {0u, 0u, 0u, 0u};
    v4u prev = (r0 > s0) ? *(const GAS v4u*)(U + (size_t)(r0 - 1) * 4096 + col) : zero;
    v4u cur = *(const GAS v4u*)(U + (size_t)r0 * 4096 + col);
#pragma unroll 4
    for (int i = 0; i < 16; ++i) { const int r = r0 + i;
        const v4u nxt = (r + 1 < s1) ? *(const GAS v4u*)(U + (size_t)(r + 1) * 4096 + col) : zero;
        const v4u bz = *(const GAS v4u*)(BZ + (size_t)r * 4096 + col);
        v4u o;
#pragma unroll
        for (int w = 0; w < 4; ++w) {
            const float y0 = w0[2 * w] * bflo(prev[w]) + w1[2 * w] * bflo(cur[w]) + w2[2 * w] * bflo(nxt[w]) + bb[2 * w];
            const float y1 = w0[2 * w + 1] * bfhi(prev[w]) + w1[2 * w + 1] * bfhi(cur[w]) + w2[2 * w + 1] * bfhi(nxt[w]) + bb[2 * w + 1];
            o[w] = pk2(bflo(bz[w]) * y0, bfhi(bz[w]) * y1); }
        *(GAS v4u*)(Gd + (size_t)r * 4096 + col) = o;
        prev = cur; cur = nxt; }
}

template <int HD> __device__ __forceinline__ void qknorm_item(bf16* X, int ld, int item, const v4u raw, const float* gain, float oscale, const float2* tab, int lane) {
    constexpr int LPH = HD / 8, NF = HD / 4;
    const int parts = ld / 512, row = item / parts, part = item % parts, col = (part * 64 + lane) * 8, d0 = col % HD;
    bf16* p = X + (size_t)row * ld + col;
    float v[8];
#pragma unroll
    for (int w = 0; w < 4; ++w) { v[2 * w] = bflo(raw[w]); v[2 * w + 1] = bfhi(raw[w]); }
    float ss = 0.f;
#pragma unroll
    for (int e = 0; e < 8; ++e) ss += v[e] * v[e];
#pragma unroll
    for (int o = 1; o < LPH; o <<= 1) ss += __shfl_xor(ss, o);
    const float rstd = 1.0f / sqrtf(ss * (1.0f / HD) + EPS);
#pragma unroll
    for (int e = 0; e < 8; ++e) v[e] = v[e] * rstd * gain[d0 + e];
    float pv[8];
#pragma unroll
    for (int e = 0; e < 8; ++e) pv[e] = __shfl_xor(v[e], LPH / 4);
    if (row < ML) {
        const int t = row & 4095, axis = d0 / (HD / 2), half = (d0 / NF) & 1, f0 = d0 % NF, pos = axis ? (t & 63) : (t >> 6);
        const float2* cs = tab + pos * NF + f0;
#pragma unroll
        for (int e = 0; e < 8; ++e) { const float2 c = cs[e]; v[e] = half ? (pv[e] * c.y + v[e] * c.x) : (v[e] * c.x - pv[e] * c.y); }
    }
    v4u o;
#pragma unroll
    for (int w = 0; w < 4; ++w) o[w] = pk2(v[2 * w] * oscale, v[2 * w + 1] * oscale);
    *(GAS v4u*)p = o;
}
template <int HD> __device__ __forceinline__ void qknorm_all(bf16* X, int ld, int nitems, const float* gain, float oscale, const float2* tab, int gw, int NGW, int lane) {
    const int parts = ld / 512;
    for (int it = gw * 4; it < nitems; it += NGW * 4) {
        v4u raw[4];
#pragma unroll
        for (int j = 0; j < 4; ++j) { const int item = it + j, row = item / parts, part = item % parts; raw[j] = *(const GAS v4u*)(X + (size_t)row * ld + (part * 64 + lane) * 8); }
#pragma unroll
        for (int j = 0; j < 4; ++j) qknorm_item<HD>(X, ld, it + j, raw[j], gain, oscale, tab, lane);
    }
}

__device__ __forceinline__ s16x4 vtr(const LAS unsigned char* p) { typedef short v4i16_t __attribute__((ext_vector_type(4))); return __builtin_bit_cast(s16x4, __builtin_amdgcn_ds_read_tr16_b64_v4i16((LAS v4i16_t*)p)); }
template <bool DIFF, int VAR = 0>
__device__ __forceinline__ void attn_phase(LAS unsigned char* lds, const bf16* Q, bf16* O, const bf16* K, const bf16* V, const bf16* Z, const int ldk,
                                           const float shift2, const float lam, const float* subnorm, const float* sink, const float oscale, const int G, const int vcu) {
    int tid_ = threadIdx.x; asm volatile("" : "+v"(tid_));
    const int tid = tid_, lane = tid & 63, wid = __builtin_amdgcn_readfirstlane(tid >> 6), r32 = lane & 31, hi = lane >> 5;
    constexpr int KSTR = 272, VSTR = 320, KBYTES = 64 * KSTR, STAGE = KBYTES + 64 * VSTR, XOFF = 0, WSOFF = 3 * STAGE;
    static_assert(WSOFF + 8 * 128 <= LDS_BARST && 65536 <= 3 * STAGE, "attention LDS map");
    constexpr int DSTEPS = DIFF ? 4 : 8;
    const int nunits = DIFF ? 128 * 34 : 2048;
    const int skey = tid >> 4, scc = tid & 15;
    LAS float* wsf = (LAS float*)(lds + WSOFF) + wid * 32;
    const int vrow = 4 * hi + ((lane & 15) >> 2), vcol = 16 * ((lane >> 4) & 1) + 4 * (lane & 3);
    for (int u = vcu, ui = 0; u < nunits; u += G, ++ui) {
        int nlat, lat0, ctx0, koff, myq0, qcol0, kd0, zcol0, kt0 = 0, qpos = 0, qb_ = 0; float sinkv = 0.f;
        if (DIFF) {
            int bh, qi; if (u < 4096) { bh = u >> 5; qi = u & 31; } else { bh = (u - 4096) >> 1; qi = 32 + ((u - 4096) & 1); }
            const int b = bh >> 5, h = bh & 31, m = wid >> 2, qs = wid & 3; (void)ui;
            int qrow0; if (qi < 32) { qrow0 = b * 4096 + 128 * qi; nlat = 64; } else { qrow0 = ML + b * 256 + 128 * (qi - 32); nlat = 0; }
            lat0 = b * 4096; ctx0 = ML + b * 256; koff = h * 128; myq0 = qrow0 + 32 * qs; qcol0 = h * 128 + 64 * m; kd0 = 64 * m; zcol0 = h * 128;
        } else {
            const int b = u >> 9, kvh = (u >> 6) & 7, qb = u & 63, g = wid >> 1, qs = wid & 1, head = kvh * 4 + g;
            kt0 = qb - 2 < 0 ? 0 : qb - 2; const int kt1 = qb + 2 > 63 ? 63 : qb + 2; nlat = kt1 - kt0 + 1;
            lat0 = b * 4096 + 64 * kt0; ctx0 = ML + b * 256; koff = kvh * 128; myq0 = b * 4096 + 64 * qb + 32 * qs; qcol0 = head * 128; kd0 = 0; zcol0 = head * 128;
            qpos = 64 * qb + 32 * qs + r32; sinkv = sink[head]; qb_ = qb;
        }
        const int nt = nlat + 4;
        bf16x8 qf[DSTEPS];
#pragma unroll
        for (int d = 0; d < DSTEPS; ++d) qf[d] = *(const GAS bf16x8*)(Q + (size_t)(myq0 + r32) * 4096 + qcol0 + 16 * d + 8 * hi);
        f32x16 o[4];
#pragma unroll
        for (int e = 0; e < 4; ++e)
#pragma unroll
            for (int r = 0; r < 16; ++r) o[e][r] = 0.f;
        float lsum = 0.f;
        v4u kreg[2], vreg[2];
#define ATT_TROW(tt) (((tt) < nlat) ? lat0 + 64 * (tt) : ctx0 + 64 * ((tt) - nlat))
#define ATT_LOAD(tt) do { const int r0_ = ATT_TROW(tt); _Pragma("unroll") for (int i = 0; i < 2; ++i) { const size_t go = (size_t)(r0_ + skey + 32 * i) * ldk + koff + 8 * scc; kreg[i] = *(const GAS v4u*)(K + go); vreg[i] = *(const GAS v4u*)(V + go); } } while (0)
#define ATT_WRITE(so) do { _Pragma("unroll") for (int i = 0; i < 2; ++i) { *(LAS v4u*)(lds + (so) + (skey + 32 * i) * KSTR + scc * 16) = kreg[i]; *(LAS v4u*)(lds + (so) + KBYTES + (skey + 32 * i) * VSTR + scc * 16) = vreg[i]; } } while (0)
#define ATT_QK(S0_, S1_, so) do { const LAS unsigned char* kp_ = lds + (so) + r32 * KSTR + (kd0 + 8 * hi) * 2; \
            _Pragma("unroll") for (int r = 0; r < 16; ++r) { S0_[r] = -shift2; S1_[r] = -shift2; } \
            _Pragma("unroll") for (int d = 0; d < DSTEPS; ++d) { const bf16x8 k0_ = *(const LAS bf16x8*)(kp_ + d * 32), k1_ = *(const LAS bf16x8*)(kp_ + 32 * KSTR + d * 32); \
                S0_ = __builtin_amdgcn_mfma_f32_32x32x16_bf16(k0_, qf[d], S0_, 0, 0, 0); S1_ = __builtin_amdgcn_mfma_f32_32x32x16_bf16(k1_, qf[d], S1_, 0, 0, 0); \
                } } while (0)
        ATT_LOAD(0); ATT_WRITE(0); ATT_LOAD(1); ATT_WRITE(STAGE); ATT_LOAD(2);
        __syncthreads();
        f32x16 s0, s1, n0, n1;
        constexpr bool PIPE = DIFF;
        if (PIPE) ATT_QK(s0, s1, 0);
        int so_c = 0, so_n = STAGE, so_w = 2 * STAGE;
        for (int t = 0; t < nt; ++t) {
            if (VAR != 2) { ATT_WRITE(so_w); const int tl = t + 3 < nt ? t + 3 : nt - 1; ATT_LOAD(tl); } __builtin_amdgcn_sched_barrier(0);
            if (PIPE) { const int so_q = t + 1 < nt ? so_n : so_c; ATT_QK(n0, n1, so_q); }
            else ATT_QK(s0, s1, so_c);
#pragma unroll
            for (int r = 0; r < 16; ++r) { if (VAR == 1) { s0[r] = s0[r] * 1.0001f + 0.5f; s1[r] = s1[r] * 1.0001f + 0.5f; } else { s0[r] = __builtin_amdgcn_exp2f(s0[r]); s1[r] = __builtin_amdgcn_exp2f(s1[r]); } }
            if (!DIFF && t < nlat && (kt0 + t == qb_ - 2 || kt0 + t == qb_ + 2)) { const int lim = 128; const int kb0 = 64 * (kt0 + t) - qpos;
#pragma unroll
                for (int r = 0; r < 16; ++r) { const int dd = kb0 + crow(r, hi); if (dd < -lim || dd > lim) s0[r] = 0.f; if (dd + 32 < -lim || dd + 32 > lim) s1[r] = 0.f; } }
            { float a = 0.f, b = 0.f;
#pragma unroll
              for (int r = 0; r < 16; ++r) { a += s0[r]; b += s1[r]; }
              lsum += a + b; }
            const LAS unsigned char* vp = lds + so_c + KBYTES + vrow * VSTR + vcol * 2;
#pragma unroll
            for (int kb = 0; kb < 2; ++kb)
#pragma unroll
                for (int sp = 0; sp < 2; ++sp) {
                    v4u pw;
#pragma unroll
                    for (int w = 0; w < 4; ++w) pw[w] = kb == 0 ? pk2(s0[8 * sp + 2 * w], s0[8 * sp + 2 * w + 1]) : pk2(s1[8 * sp + 2 * w], s1[8 * sp + 2 * w + 1]);
                    const bf16x8 pa = __builtin_bit_cast(bf16x8, pw);
#pragma unroll
                    for (int eb = 0; eb < 4; ++eb) {
                        bf16x8 vb;
                        if (VAR == 3) { vb = qf[(kb * 2 + sp + eb) & 3]; }
                        else { const s16x4 lo = vtr(vp + (32 * kb + 16 * sp) * VSTR + 64 * eb), hh = vtr(vp + (32 * kb + 16 * sp + 8) * VSTR + 64 * eb);
                        vb = (bf16x8){lo[0], lo[1], lo[2], lo[3], hh[0], hh[1], hh[2], hh[3]}; }
                        o[eb] = __builtin_amdgcn_mfma_f32_32x32x16_bf16(pa, vb, o[eb], 0, 0, 0); } }
            if (VAR != 4) __syncthreads();
            if (PIPE) { s0 = n0; s1 = n1; }
            { const int tmp = so_c; so_c = so_n; so_n = so_w; so_w = tmp; }
        }
#undef ATT_TROW
#undef ATT_LOAD
#undef ATT_WRITE
#undef ATT_QK
        float lt = lsum + __shfl_xor(lsum, 32);
        if (!DIFF) lt += __builtin_amdgcn_exp2f(sinkv * LOG2E - shift2);
        if (hi == 0) wsf[r32] = lt;
        LDS_WAIT();
        float rl[16];
#pragma unroll
        for (int r = 0; r < 16; ++r) rl[r] = 1.0f / wsf[crow(r, hi)];
        LDS_WAIT();
        if (DIFF) {
            LAS float* X = (LAS float*)(lds + XOFF) + (wid & 3) * 4096 + lane;
            if (wid >= 4) {
#pragma unroll
                for (int eb = 0; eb < 4; ++eb)
#pragma unroll
                    for (int r = 0; r < 16; ++r) X[(eb * 16 + r) * 64] = o[eb][r] * rl[r] * lam;
            }
            __syncthreads();
            if (wid < 4) {
                float ssq[16];
#pragma unroll
                for (int r = 0; r < 16; ++r) ssq[r] = 0.f;
#pragma unroll
                for (int eb = 0; eb < 4; ++eb)
#pragma unroll
                    for (int r = 0; r < 16; ++r) { const float v = o[eb][r] * rl[r] - X[(eb * 16 + r) * 64]; o[eb][r] = v; ssq[r] += v * v; }
#pragma unroll
                for (int r = 0; r < 16; ++r) { float s = ssq[r];
#pragma unroll
                    for (int of = 1; of < 32; of <<= 1) s += __shfl_xor(s, of);
                    ssq[r] = oscale / sqrtf(s * (1.0f / 128.0f) + EPS); }
#pragma unroll
                for (int eb = 0; eb < 4; ++eb) { const float gn = subnorm[32 * eb + r32];
                    unsigned zz[16];
#pragma unroll
                    for (int r = 0; r < 16; ++r) zz[r] = (unsigned)((const GAS bf16*)Z)[(size_t)(myq0 + crow(r, hi)) * 4096 + zcol0 + 32 * eb + r32];
#pragma unroll
                    for (int r = 0; r < 16; ++r) { const size_t off = (size_t)(myq0 + crow(r, hi)) * 4096 + zcol0 + 32 * eb + r32;
                        ((GAS bf16*)O)[off] = (bf16)f2bf(o[eb][r] * ssq[r] * gn * pg8::silu_f(bflo(zz[r]))); } }
            }
            __syncthreads();
        } else {
#pragma unroll
            for (int eb = 0; eb < 4; ++eb) { unsigned zz[16];
#pragma unroll
                for (int r = 0; r < 16; ++r) zz[r] = (unsigned)((const GAS bf16*)Z)[(size_t)(myq0 + crow(r, hi)) * 4096 + zcol0 + 32 * eb + r32];
#pragma unroll
                for (int r = 0; r < 16; ++r) { const size_t off = (size_t)(myq0 + crow(r, hi)) * 4096 + zcol0 + 32 * eb + r32;
                    ((GAS bf16*)O)[off] = (bf16)f2bf(o[eb][r] * rl[r] * pg8::silu_f(bflo(zz[r]))); } }
        }
    }
}

#define RLX_AGENT __ATOMIC_RELAXED, __HIP_MEMORY_SCOPE_AGENT
#define XB_TMO      128
#define XB_XCNT(j)  (256  + 64 * (j))
#define XB_XSUB(j)  (1280 + 64 * (j))
#define XB_XGEN(j)  (2304 + 64 * (j))
#define XB_TOP      3328
#define XB_TOPGEN   3392
#define XCD_BAR_WORDS 3456
#define XB_SPIN_CAP (1u << 18)

__device__ __forceinline__ unsigned xb_ld(unsigned* p)              { return __hip_atomic_load(p, __ATOMIC_RELAXED, __HIP_MEMORY_SCOPE_AGENT); }
__device__ __forceinline__ unsigned xb_add(unsigned* p, unsigned v) { return __hip_atomic_fetch_add(p, v, __ATOMIC_RELAXED, __HIP_MEMORY_SCOPE_AGENT); }
__device__ __forceinline__ unsigned xb_xcc_id() { return (unsigned)__builtin_amdgcn_s_getreg((3 << 11) | 20) & 0xFu; }
#define XB_SPIN(cond, bar) do { unsigned _sp = 0; while (cond) { __builtin_amdgcn_s_sleep(1); \
    if ((++_sp & 255u) == 0u) { if (xb_ld(&(bar)[XB_TMO])) break; if (_sp > XB_SPIN_CAP) { atomicAdd(&(bar)[XB_TMO], 1u); break; } } } } while (0)

struct XcdBarrier {
    unsigned* bar; unsigned x;
    volatile LAS unsigned* st;
};

__device__ __forceinline__ XcdBarrier xcd_barrier_post(unsigned* bar, volatile LAS unsigned* st) {
    XcdBarrier b; b.bar = bar; b.x = xb_xcc_id(); b.st = st;
    if (threadIdx.x == 0) (void)xb_add(&bar[XB_XCNT(b.x)], 1u);
    return b;
}
__device__ __forceinline__ void xcd_barrier_complete(unsigned* bar, unsigned x, unsigned& nloc, unsigned& nx) {
    const unsigned G = gridDim.x * gridDim.y * gridDim.z;
    unsigned sum, cnt, mine, sp = 0u;
    for (;;) {
        sum = 0u; cnt = 0u; mine = 0u;
#pragma unroll
        for (unsigned j = 0; j < 16; ++j) { const unsigned c = xb_ld(&bar[XB_XCNT(j)]); sum += c; cnt += (c > 0u) ? 1u : 0u; mine = (j == x) ? c : mine; }
        if (sum == G) break;
        __builtin_amdgcn_s_sleep(1);
        if ((++sp & 255u) == 0u) { if (xb_ld(&bar[XB_TMO])) break; if (sp > XB_SPIN_CAP) { atomicAdd(&bar[XB_TMO], 1u); break; } }
    }
    nloc = mine > 0u ? mine : 1u; nx = cnt > 0u ? cnt : 1u;
}

__device__ __forceinline__ void xcd_barrier(const XcdBarrier& b) {
    asm volatile("s_waitcnt vmcnt(0)" ::: "memory");
    __syncthreads();
    if (threadIdx.x == 0) {
        unsigned* bar = b.bar;
        __builtin_amdgcn_s_waitcnt(0);
        unsigned nloc = b.st[0], nx = b.st[1];
        if (nloc == 0u) { xcd_barrier_complete(bar, b.x, nloc, nx); b.st[0] = nloc; b.st[1] = nx; }
        const unsigned old = xb_add(&bar[XB_XSUB(b.x)], 1u);
        const unsigned gen = old / nloc;
        if (old + 1u == (gen + 1u) * nloc) {
            __builtin_amdgcn_fence(__ATOMIC_RELEASE, "agent");
            asm volatile("s_waitcnt vmcnt(0)" ::: "memory");
            const unsigned og = xb_add(&bar[XB_TOP], 1u);
            const unsigned tg = og / nx;
            if (og + 1u == (tg + 1u) * nx) xb_add(&bar[XB_TOPGEN], 1u);
            else XB_SPIN(xb_ld(&bar[XB_TOPGEN]) == tg, bar);
            __builtin_amdgcn_fence(__ATOMIC_ACQUIRE, "agent");
            xb_add(&bar[XB_XGEN(b.x)], 1u);
            asm volatile("s_waitcnt vmcnt(0)" ::: "memory");
        } else {
            XB_SPIN(xb_ld(&bar[XB_XGEN(b.x)]) == gen, bar);
            __builtin_amdgcn_fence(__ATOMIC_ACQUIRE, "agent");
            asm volatile("s_waitcnt vmcnt(0)" ::: "memory");
        }
    }
    __syncthreads();
}

#ifndef G2_ALIGN
#define G2_ALIGN false
#endif
#ifndef MK_SINGLE
#define MK_SINGLE 1
#endif
__global__ void __launch_bounds__(NWAVES * 64, 2) mk_fwd(Args a) {
    extern __shared__ __attribute__((aligned(16))) unsigned char lds_raw[];
    LAS unsigned char* lds = (LAS unsigned char*)lds_raw;
    cg::grid_group grid = cg::this_grid();
    const int lo = a.ph_lo, hi = a.ph_hi;
#define PHASE_LOCALS \
    int tid_ = threadIdx.x; asm volatile("" : "+v"(tid_)); const int tid = tid_, lane = tid & 63, wave = __builtin_amdgcn_readfirstlane(tid >> 6); (void)lane; (void)wave; \
    int G_ = gridDim.x, bx_ = blockIdx.x; asm volatile("" : "+s"(G_), "+s"(bx_)); const int G = G_, bx = bx_, vcu = (G % 8 == 0) ? (bx % 8) * (G / 8) + bx / 8 : bx; \
    const int gw = vcu * NWAVES + wave, NGW = G * NWAVES; (void)gw; (void)NGW; \
    unsigned char* ws_ = a.ws; asm volatile("" : "+s"(ws_)); unsigned char* ws = (unsigned char*)(GAS unsigned char*)ws_; \
    float* mod = (float*)(ws + WS_MOD); float2* tab64 = (float2*)(ws + WS_TAB); float2* tab128 = tab64 + 64 * 16; (void)mod; (void)tab64; (void)tab128; \
    bf16* WTin = (bf16*)(ws + WS_WTIN); bf16* WTout = (bf16*)(ws + WS_WTOUT); bf16* HA = (bf16*)(ws + WS_HA); float* cbuf = (float*)(ws + WS_CBUF); (void)WTin; (void)WTout; (void)HA; (void)cbuf; \
    bf16* S0 = (bf16*)(ws + WS_SLOT); bf16* S1 = (bf16*)(ws + WS_SLOT + SLOT_BYTES); bf16* S2 = (bf16*)(ws + WS_SLOT + 2 * SLOT_BYTES); bf16* S3 = (bf16*)(ws + WS_SLOT + 3 * SLOT_BYTES); (void)S0; (void)S1; (void)S2; (void)S3; \
    LAS float* scr = (LAS float*)(lds + wave * 16384); (void)scr;
#define IN(k) (lo <= (k) && (k) < hi)
#define SEAM(k) do { if ((k) + 1 < hi) { if ((k) == 0) grid.sync(); else { unsigned char* wsb_ = a.ws; asm volatile("" : "+s"(wsb_)); XcdBarrier bar_; bar_.bar = (unsigned*)(wsb_ + WS_BAR); bar_.x = xb_xcc_id(); bar_.st = (volatile LAS unsigned*)(lds + LDS_BARST); xcd_barrier(bar_); } } } while (0)
    if (hi - lo > 1) {
        if (threadIdx.x < 2) ((volatile LAS unsigned*)(lds + LDS_BARST))[threadIdx.x] = 0u;
        __syncthreads();
        unsigned char* wsb_ = a.ws; (void)xcd_barrier_post((unsigned*)(wsb_ + WS_BAR), (volatile LAS unsigned*)(lds + LDS_BARST));
    }

    if (IN(0)) { PHASE_LOCALS
        transpose_all<MAP_CONV>(argp(7), DM, 4 * DI, WTin, scr, gw, NGW, lane);
        transpose_all<MAP_ID>(argp(10), DI, DM, WTout, scr, gw, NGW, lane);
#ifdef PROBE_DUP_TRANS
        transpose_all<MAP_CONV>(argp(7), DM, 4 * DI, WTin, scr, gw, NGW, lane);
        transpose_all<MAP_ID>(argp(10), DI, DM, WTout, scr, gw, NGW, lane);
#endif
        for (int it = gw; it < 6144; it += NGW) mod_item(mod, scr, it, lane);
        if (bx == 0) {
            for (int i = tid; i < 64 * 16; i += NWAVES * 64) { const int pos = i >> 4, f = i & 15; const float ang = (float)pos * exp2f(-(float)f * (13.287712379549449f / 16.0f)); tab64[i] = make_float2(cosf(ang), sinf(ang)); }
            for (int i = tid; i < 64 * 32; i += NWAVES * 64) { const int pos = i >> 5, f = i & 31; const float ang = (float)pos * exp2f(-(float)f * (13.287712379549449f / 32.0f)); tab128[i] = make_float2(cosf(ang), sinf(ang)); }
        }
        SEAM(0);
    }
#pragma unroll
    for (int l = 0; l < 4; ++l) {
        const int base = 1 + 5 * l, kind = (l == 3) ? 0 : l;
        const int LB = l == 0 ? 4 : l == 1 ? 11 : l == 2 ? 23 : 31, LW = l == 0 ? 10 : l == 1 ? 22 : l == 2 ? 30 : 37;
#define XCUR (l == 0 ? argp(0) : (const float*)(const GAS float*)a.out)
#define CCUR (l == 0 ? argp(2) : (const float*)cbuf)
        const int m1 = (l == 3) ? ML : MT;
        if (IN(base)) { PHASE_LOCALS
            if (l > 0) {
                if (kind == 0) transpose_all<MAP_CONV>(argp(LB + 3), DM, 4 * DI, WTin, scr, gw, NGW, lane);
                else if (kind == 1) transpose_all<MAP_P32>(argp(LB + 3), DM, 4 * DI, WTin, scr, gw, NGW, lane);
                else transpose_all<MAP_P32>(argp(LB + 3), DM, 2 * DI + 2048, WTin, scr, gw, NGW, lane);
                transpose_all<MAP_ID>(argp(LW), DI, DM, WTout, scr, gw, NGW, lane);
            }
#ifdef PROBE_DUP_TRANS
            if (l > 0) {
                if (kind == 0) transpose_all<MAP_CONV>(argp(LB + 3), DM, 4 * DI, WTin, scr, gw, NGW, lane);
                else if (kind == 1) transpose_all<MAP_P32>(argp(LB + 3), DM, 4 * DI, WTin, scr, gw, NGW, lane);
                else transpose_all<MAP_P32>(argp(LB + 3), DM, 2 * DI + 2048, WTin, scr, gw, NGW, lane);
                transpose_all<MAP_ID>(argp(LW), DI, DM, WTout, scr, gw, NGW, lane);
            }
#endif
            const float* xc = XCUR; const float* cc = CCUR; const float* ng = argp(LB);
            float* slab = (float*)(ws + WS_SLAB); (void)slab;
            for (int row = gw; row < m1; row += NGW) { const bool lat = row < ML;
                if (lat || l == 0) norm_row(lat ? xc + (size_t)row * DM : cc + (size_t)(row - ML) * DM, ng, mod + (size_t)(l * 5 + (lat ? (row >> 12) : 4)) * 6144, HA + (size_t)row * DM, lane);
                else { const float* prev = l == 1 ? argp(2) : (const float*)cbuf;
                    norm_row(prev + (size_t)(row - ML) * DM, ng, mod + (size_t)(l * 5 + 4) * 6144, HA + (size_t)row * DM, lane, slab + (size_t)(row - ML) * DM, mod + (size_t)((l - 1) * 5 + 4) * 6144 + 4096, cbuf + (size_t)(row - ML) * DM); } }
#ifdef PROBE_DUP_NORMCONV
            {
            const float* xc = XCUR; const float* cc = CCUR; const float* ng = argp(LB);
            float* slab = (float*)(ws + WS_SLAB); (void)slab;
            for (int row = gw; row < m1; row += NGW) { const bool lat = row < ML;
                if (lat || l == 0) norm_row(lat ? xc + (size_t)row * DM : cc + (size_t)(row - ML) * DM, ng, mod + (size_t)(l * 5 + (lat ? (row >> 12) : 4)) * 6144, HA + (size_t)row * DM, lane);
                else { const float* prev = l == 1 ? argp(2) : (const float*)cbuf;
                    norm_row(prev + (size_t)(row - ML) * DM, ng, mod + (size_t)(l * 5 + 4) * 6144, HA + (size_t)row * DM, lane, slab + (size_t)(row - ML) * DM, mod + (size_t)((l - 1) * 5 + 4) * 6144 + 4096, cbuf + (size_t)(row - ML) * DM); } }
            }
#endif
            SEAM(base);
        }
        if (IN(base + 1)) { PHASE_LOCALS
            if (kind == 0) { pg8::Gemm g{HA, WTin, m1, 4 * DI, DM}; pg8::StaticOrder S; S.init(m1, 4 * DI, G, bx); pg8::EpiConv E{S0, S1};

#ifndef NO_G1C
                pg8::gemm_phase<pg8::EpiConv, pg8::StaticOrder, true, true>(lds, g, S, E);
#ifdef PROBE_DUP_G1
                pg8::gemm_phase<pg8::EpiConv, pg8::StaticOrder, true, true>(lds, g, S, E);
#endif
#endif
 }
            else if (kind == 1) { pg8::Gemm g{HA, WTin, m1, 4 * DI, DM}; pg8::StaticOrder S; S.init(m1, 4 * DI, G, bx); typedef pg8::EpiSplit<1, (long)(SLOT_BYTES / 2), (long)MT> EpiS1; EpiS1 E{S0};

#if !defined(NO_G1S) && !defined(NO_G1S1)
                pg8::gemm_phase<EpiS1, pg8::StaticOrder, true, true>(lds, g, S, E);
#ifdef PROBE_DUP_G1
                pg8::gemm_phase<EpiS1, pg8::StaticOrder, true, true>(lds, g, S, E);
#endif
#endif
 }
            else { pg8::Gemm g{HA, WTin, m1, 2 * DI + 2048, DM}; pg8::StaticOrder S; S.init(m1, 2 * DI + 2048, G, bx); typedef pg8::EpiSplit<2, (long)(SLOT_BYTES / 2), (long)MT> EpiS2; EpiS2 E{S0};

#if !defined(NO_G1S) && !defined(NO_G1S2)
                pg8::gemm_phase<EpiS2, pg8::StaticOrder, true, true>(lds, g, S, E);
#ifdef PROBE_DUP_G1
                pg8::gemm_phase<EpiS2, pg8::StaticOrder, true, true>(lds, g, S, E);
#endif
#endif
 }
            SEAM(base + 1);
        }
        if (IN(base + 2)) { PHASE_LOCALS
            if (kind == 0) { for (int it = bx; it < m1 / 16; it += G) conv_item(S0, S1, S2, argp(LB + 4), argp(LB + 5), it, tid); }
#ifdef PROBE_DUP_NORMCONV
            if (kind == 0) { for (int it = bx; it < m1 / 16; it += G) conv_item(S0, S1, S2, argp(LB + 4), argp(LB + 5), it, tid); }
#endif
            else if (kind == 1) {
                qknorm_all<64>(S0, DI, MT * 8, argp(LB + 4), 0.125f * LOG2E, tab64, gw, NGW, lane);
                qknorm_all<64>(S1, DI, MT * 8, argp(LB + 5), 1.0f, tab64, gw, NGW, lane);
            } else {
                qknorm_all<128>(S0, DI, ML * 8, argp(LB + 4), 0.08838834764831845f * LOG2E, tab128, gw, NGW, lane);
                qknorm_all<128>(S1, 1024, MT * 2, argp(LB + 5), 1.0f, tab128, gw, NGW, lane);
            }
            SEAM(base + 2);
        }
        if (kind != 0 && IN(base + 3)) { PHASE_LOCALS
            if (kind == 1) {
                const float gq = wave_max(fabsf(argp(LB + 4)[lane])), gk = wave_max(fabsf(argp(LB + 5)[lane]));
                const float d1 = wave_sum(argp(LB + 6)[lane] * argp(LB + 7)[lane]), d2 = wave_sum(argp(LB + 8)[lane] * argp(LB + 9)[lane]);
                const float lam = expf(d1) - expf(d2) + LAM_INIT1;
#ifndef NO_ATTN1
#ifdef PROBE_DUP_ATTN
                attn_phase<true, PROBE_DUP_ATTN - 1>(lds, S0, (bf16*)(ws + WS_END), S1, S2, S3, DI, 8.0f * gq * gk * LOG2E, lam, argp(LB + 10), nullptr, 1.0f - LAM_INIT1, G, vcu);
#endif
                attn_phase<true>(lds, S0, S0, S1, S2, S3, DI, 8.0f * gq * gk * LOG2E, lam, argp(LB + 10), nullptr, 1.0f - LAM_INIT1, G, vcu);
#endif
            } else {
                const float gq = wave_max(fmaxf(fabsf(argp(LB + 4)[lane]), fabsf(argp(LB + 4)[lane + 64]))), gk = wave_max(fmaxf(fabsf(argp(LB + 5)[lane]), fabsf(argp(LB + 5)[lane + 64])));
#ifndef NO_ATTN2
#ifdef PROBE_DUP_WATTN
                attn_phase<false>(lds, S0, (bf16*)(ws + WS_END), S1, S1 + (size_t)MT * 1024, S3, 1024, 11.313708498984761f * gq * gk * LOG2E, 0.f, nullptr, argp(LB + 6), 1.0f, G, vcu);
#endif
                attn_phase<false>(lds, S0, S0, S1, S1 + (size_t)MT * 1024, S3, 1024, 11.313708498984761f * gq * gk * LOG2E, 0.f, nullptr, argp(LB + 6), 1.0f, G, vcu);
#endif
            }
            SEAM(base + 3);
        }
        if (IN(base + 4)) { PHASE_LOCALS
            { pg8::Gemm g{kind == 0 ? S2 : S0, WTout, ML, DM, DI}; pg8::StaticOrder S; S.init(ML, DM, G, bx);
              pg8::EpiResid E{XCUR, (float*)(GAS float*)a.out, mod + (size_t)l * 5 * 6144};
              pg8::gemm_phase<pg8::EpiResid, pg8::StaticOrder, G2_ALIGN, true>(lds, g, S, E);
#ifdef PROBE_DUP_G2L0
              if (l == 0) pg8::gemm_phase<pg8::EpiResid, pg8::StaticOrder, G2_ALIGN, true>(lds, g, S, E);
#endif
            }
            if (l < 2) {
                pg8::Gemm g{kind == 0 ? S2 : S0, WTout, MT, DM, 512, DI}; pg8::SplitOrder S{bx, G}; pg8::EpiSlab E{(float*)(ws + WS_SLAB)};
#ifndef NO_SPLIT
                pg8::gemm_phase<pg8::EpiSlab, pg8::SplitOrder, true, true>(lds, g, S, E);
#endif
            }
            SEAM(base + 4);
        }
    }
#undef IN
#undef SEAM
}

extern "C" void kernel_launch(void* const* d_in, const int* in_sizes, int n_in, void* d_out, int out_size, void* d_ws, size_t ws_size, hipStream_t stream) {
    static int grid = 0;
    if (grid == 0) {
        if (n_in != 38 || in_sizes[0] != ML * DM || out_size != ML * DM || ws_size < WS_END) { fprintf(stderr, "kernel_launch: unexpected shapes (n_in %d, out %d, ws %zu < %zu)\n", n_in, out_size, ws_size, (size_t)WS_END); grid = -1; return; }
        int dev = 0, cus = 0, per_cu = 0;
        if (hipGetDevice(&dev) != hipSuccess || hipDeviceGetAttribute(&cus, hipDeviceAttributeMultiprocessorCount, dev) != hipSuccess) { grid = -1; return; }
        if (hipFuncSetAttribute((const void*)mk_fwd, hipFuncAttributeMaxDynamicSharedMemorySize, LDS_BYTES) != hipSuccess) { fprintf(stderr, "kernel_launch: hipFuncSetAttribute failed\n"); grid = -1; return; }
        if (hipOccupancyMaxActiveBlocksPerMultiprocessor(&per_cu, (const void*)mk_fwd, NWAVES * 64, LDS_BYTES) != hipSuccess || per_cu < 1) { fprintf(stderr, "kernel_launch: occupancy query says %d\n", per_cu); per_cu = 1; }
        (void)hipGetLastError();
        grid = cus;
    }
    if (grid < 0) return;
    (void)hipMemsetAsync((char*)d_ws + WS_MOD, 0, MOD_ZERO_BYTES, stream);
    Args a{};
    for (int i = 0; i < 38; ++i) a.in[i] = (const float*)d_in[i];
    a.out = (float*)d_out; a.ws = (unsigned char*)d_ws;
#if MK_SINGLE
    a.ph_lo = 0; a.ph_hi = NPH;
    void* params[] = {&a};
    const hipError_t e = hipLaunchCooperativeKernel((const void*)mk_fwd, dim3(grid), dim3(NWAVES * 64), params, LDS_BYTES, stream);
    if (e != hipSuccess) fprintf(stderr, "kernel_launch: cooperative launch failed: %s (grid %d)\n", hipGetErrorString(e), grid);
#else
    for (int ph = 0; ph < NPH; ++ph) {
        if (ph == 4 || ph == 19) continue;
        a.ph_lo = ph; a.ph_hi = ph + 1;
        hipLaunchKernelGGL(mk_fwd, dim3(grid), dim3(NWAVES * 64), LDS_BYTES, stream, a);
    }
#endif
}
```

```cpp
#include <hip/hip_runtime.h>
#include <hip/hip_cooperative_groups.h>
#include <cstdio>
#include <cstdint>
#define MK_SINGLE 1
namespace pg8 {
#define PG8_LAS __attribute__((address_space(3)))
typedef unsigned short bf16_t;
typedef short bf16x8 __attribute__((ext_vector_type(8)));
typedef float f32x4 __attribute__((ext_vector_type(4)));
typedef unsigned u32x4 __attribute__((ext_vector_type(4)));
constexpr int BM = 256, BK = 64, HALF = 128, HTB = HALF * BK * 2  , STAGE_BYTES = 8 * HTB, NXCD = 8, WGM = 8;

__host__ __device__ __forceinline__ int lds_byte(int r, int c) { const int st = (r >> 4) * 2 + (c >> 5), rr = r & 15, cc = c & 31, ob = rr * 64 + cc * 2; return st * 1024 + (ob ^ (((ob >> 9) & 1) << 5)); }
__host__ __device__ __forceinline__ void stage_rc(int b, int& R, int& C) { const int st = b / 1024, sb = b % 1024, swz = sb ^ (((sb >> 9) & 1) << 5); R = (st >> 1) * 16 + swz / 64; C = (st & 1) * 32 + (swz % 64) / 2; }
__host__ __device__ __forceinline__ int perm32(int rho) { const int n = rho >> 4, i = rho & 15; return 8 * (i >> 2) + 4 * n + (i & 3); }

struct Unit { int pm, pn, ko; };
struct Gemm { const bf16_t* A; const bf16_t* Bt; int M, N, K; int ld = 0; };

struct StaticOrder {
    int nM, nN, nwg, G, c;
    __host__ __device__ void init(int M, int N, int G_, int c_) { nM = M / BM; nN = N / BM; nwg = nM * nN; G = G_; c = c_; }
    __host__ __device__ bool next(int i, Unit& u) const {
        const long L = (long)i * G + c; if (L >= nwg) return false;
        int wgid = (int)L; { const int q = nwg / NXCD, r = nwg % NXCD, xcd = wgid % NXCD, off = wgid / NXCD; wgid = (xcd < r ? xcd * (q + 1) : r * (q + 1) + (xcd - r) * q) + off; }
        const int nig = WGM * nN, gid = wgid / nig, fm = gid * WGM, gsz = (nM - fm) < WGM ? (nM - fm) : WGM;
        u.pm = fm + ((wgid % nig) % gsz); u.pn = (wgid % nig) / gsz; u.ko = 0; return true;
    }
    __device__ __forceinline__ void a_ready(const Unit&) const {}
    __device__ __forceinline__ void done(const Unit&) const {}
};
struct SplitOrder {
    int c, G;
    __host__ __device__ bool next(int i, Unit& u) const { const int L = i * G + c; if (L >= 256) return false; u.pm = 64 + (L >> 6); u.pn = (L >> 3) & 7; u.ko = (L & 7) * 512; return true; }
    __device__ __forceinline__ void a_ready(const Unit&) const {}
    __device__ __forceinline__ void done(const Unit&) const {}
};
__device__ __forceinline__ unsigned cvt_pk_bf16(float lo, float hi) { unsigned r; asm volatile("v_cvt_pk_bf16_f32 %0, %1, %2" : "=v"(r) : "v"(lo), "v"(hi)); return r; }
typedef float f32x2 __attribute__((ext_vector_type(2)));
typedef unsigned u32x2 __attribute__((ext_vector_type(2)));
#define PG8_GAS __attribute__((address_space(1)))
__device__ __forceinline__ float silu_f(float z) { return z * __builtin_amdgcn_rcpf(1.0f + __builtin_amdgcn_exp2f(-1.4426950408889634f * z)); }

template <int KIND, long SLOT, long MROWS> struct EpiSplit {
    static constexpr bool PERM = false, AFTER_DRAIN = false;
    bf16_t* base;
    __device__ __forceinline__ void operator()(const f32x4 (&acc)[2][2][4][2], const Unit& u, int wr, int wc, int fr, int fq) const {
        const int pn = u.pn; long boff; int ld, tt;
        if (KIND == 1) { const int s = pn >> 4; boff = (long)s * SLOT; ld = 4096; tt = s << 4; }
        else { if (pn < 16) { boff = 0; ld = 4096; tt = 0; } else if (pn < 20) { boff = SLOT; ld = 1024; tt = 16; } else if (pn < 24) { boff = SLOT + MROWS * 1024; ld = 1024; tt = 20; } else { boff = 3 * SLOT; ld = 4096; tt = 24; } }
        const int row0 = u.pm * BM + wr * 64 + fr, col0 = (pn - tt) * BM + wc * 32 + 8 * fq;
        bf16_t* B = base + boff + (size_t)row0 * ld + col0;
#pragma unroll
        for (int ai = 0; ai < 2; ++ai)
#pragma unroll
            for (int m = 0; m < 4; ++m) { bf16_t* rowp = B + (size_t)((ai * HALF + m * 16) * ld);
#pragma unroll
                for (int bj = 0; bj < 2; ++bj) { const f32x4 v0 = acc[ai][bj][m][0], v1 = acc[ai][bj][m][1];
                    u32x4 w; w.x = cvt_pk_bf16(v0[0], v0[1]); w.y = cvt_pk_bf16(v0[2], v0[3]); w.z = cvt_pk_bf16(v1[0], v1[1]); w.w = cvt_pk_bf16(v1[2], v1[3]);
                    *(PG8_GAS u32x4*)(rowp + bj * HALF) = w; } }
    }
};
template <long SLOT> struct EpiDiff {
    static constexpr bool PERM = false, AFTER_DRAIN = false;
    bf16_t* base; const float* qn; const float* kn; const float* tab; float qscale;
    __device__ __forceinline__ void operator()(const f32x4 (&acc)[2][2][4][2], const Unit& u, int wr, int wc, int fr, int fq) const {
        const int pn = u.pn;
        if (pn >= 32) {
            const int s = pn >> 4; const int row0 = u.pm * BM + wr * 64 + fr, col0 = (pn - (s << 4)) * BM + wc * 32 + 8 * fq;
            bf16_t* B = base + (long)s * SLOT + (size_t)row0 * 4096 + col0;
#pragma unroll
            for (int ai = 0; ai < 2; ++ai)
#pragma unroll
                for (int m = 0; m < 4; ++m) { bf16_t* rowp = B + (size_t)((ai * HALF + m * 16) * 4096);
#pragma unroll
                    for (int bj = 0; bj < 2; ++bj) { const f32x4 v0 = acc[ai][bj][m][0], v1 = acc[ai][bj][m][1];
                        u32x4 w; w.x = cvt_pk_bf16(v0[0], v0[1]); w.y = cvt_pk_bf16(v0[2], v0[3]); w.z = cvt_pk_bf16(v1[0], v1[1]); w.w = cvt_pk_bf16(v1[2], v1[3]);
                        *(PG8_GAS u32x4*)(rowp + bj * HALF) = w; } }
            return;
        }
        const bool isq = pn < 16, latent = u.pm < 64;
        const float* gain = isq ? qn : kn; const float osc = isq ? qscale : 1.0f;
        f32x4 gg[2][2];
#pragma unroll
        for (int bj = 0; bj < 2; ++bj)
#pragma unroll
            for (int n = 0; n < 2; ++n) gg[bj][n] = *(const PG8_GAS f32x4*)(gain + 32 * bj + 16 * n + 4 * fq);
        bf16_t* B = base + (isq ? 0 : SLOT) + (size_t)(u.pm * BM + wr * 64 + fr) * 4096 + (pn & 15) * BM + 64 * wc + 16 * fq;
#pragma unroll
        for (int ai = 0; ai < 2; ++ai) {
            const int prow = (4 * u.pm + 2 * ai + wr) & 63;
            const f32x4 ra = *(const PG8_GAS f32x4*)(tab + (prow * 16 + 4 * fq) * 2), rb = *(const PG8_GAS f32x4*)(tab + (prow * 16 + 4 * fq) * 2 + 4);
#pragma unroll
            for (int m = 0; m < 4; ++m) {
                const int pcol = 16 * m + fr;
                const f32x4 ca = *(const PG8_GAS f32x4*)(tab + (pcol * 16 + 4 * fq) * 2), cb = *(const PG8_GAS f32x4*)(tab + (pcol * 16 + 4 * fq) * 2 + 4);
                f32x4 y[2][2]; float ss = 0.f;
#pragma unroll
                for (int bj = 0; bj < 2; ++bj)
#pragma unroll
                    for (int n = 0; n < 2; ++n) { y[bj][n] = acc[ai][bj][m][n]; ss += (y[bj][n][0] * y[bj][n][0] + y[bj][n][1] * y[bj][n][1]) + (y[bj][n][2] * y[bj][n][2] + y[bj][n][3] * y[bj][n][3]); }
                ss += __shfl_xor(ss, 16); ss += __shfl_xor(ss, 32);
                const float rstd = 1.0f / sqrtf(ss * (1.0f / 64.0f) + 1e-6f);
#pragma unroll
                for (int bj = 0; bj < 2; ++bj)
#pragma unroll
                    for (int n = 0; n < 2; ++n) y[bj][n] = y[bj][n] * rstd * gg[bj][n];
                if (latent) {
#pragma unroll
                    for (int bj = 0; bj < 2; ++bj) { const f32x4 A = bj == 0 ? ra : ca, Bv = bj == 0 ? rb : cb;
                        const f32x4 c = {A[0], A[2], Bv[0], Bv[2]}, sn = {A[1], A[3], Bv[1], Bv[3]};
                        const f32x4 t1 = y[bj][0], t2 = y[bj][1]; y[bj][0] = t1 * c - t2 * sn; y[bj][1] = t1 * sn + t2 * c; }
                }
                bf16_t* rowp = B + (size_t)((ai * HALF + m * 16) * 4096);
#pragma unroll
                for (int bj = 0; bj < 2; ++bj) { const f32x4 v0 = y[bj][0] * osc, v1 = y[bj][1] * osc;
                    u32x4 w; w.x = cvt_pk_bf16(v0[0], v0[1]); w.y = cvt_pk_bf16(v0[2], v0[3]); w.z = cvt_pk_bf16(v1[0], v1[1]); w.w = cvt_pk_bf16(v1[2], v1[3]);
                    *(PG8_GAS u32x4*)(rowp + 8 * bj) = w; }
            }
        }
    }
};
template <long SLOT, long MROWS> struct EpiWin {
    static constexpr bool PERM = false, AFTER_DRAIN = false;
    bf16_t* base; const float* qn; const float* kn; const float* tab; float qscale; PG8_LAS float* xch;
    __device__ __forceinline__ void operator()(const f32x4 (&acc)[2][2][4][2], const Unit& u, int wr, int wc, int fr, int fq) const {
        const int pn = u.pn;
        if (pn >= 20) {
            long boff; int ld, tt; if (pn < 24) { boff = SLOT + MROWS * 1024; ld = 1024; tt = 20; } else { boff = 3 * SLOT; ld = 4096; tt = 24; }
            const int row0 = u.pm * BM + wr * 64 + fr, col0 = (pn - tt) * BM + wc * 32 + 8 * fq;
            bf16_t* B = base + boff + (size_t)row0 * ld + col0;
#pragma unroll
            for (int ai = 0; ai < 2; ++ai)
#pragma unroll
                for (int m = 0; m < 4; ++m) { bf16_t* rowp = B + (size_t)((ai * HALF + m * 16) * ld);
#pragma unroll
                    for (int bj = 0; bj < 2; ++bj) { const f32x4 v0 = acc[ai][bj][m][0], v1 = acc[ai][bj][m][1];
                        u32x4 w; w.x = cvt_pk_bf16(v0[0], v0[1]); w.y = cvt_pk_bf16(v0[2], v0[3]); w.z = cvt_pk_bf16(v1[0], v1[1]); w.w = cvt_pk_bf16(v1[2], v1[3]);
                        *(PG8_GAS u32x4*)(rowp + bj * HALF) = w; } }
            return;
        }
        const bool isq = pn < 16, latent = u.pm < 64; const int w1 = wc & 1;
        const float* gain = isq ? qn : kn; const float osc = isq ? qscale : 1.0f;
        f32x4 gg[2][2];
#pragma unroll
        for (int bj = 0; bj < 2; ++bj)
#pragma unroll
            for (int n = 0; n < 2; ++n) gg[bj][n] = *(const PG8_GAS f32x4*)(gain + 64 * w1 + 32 * bj + 16 * n + 4 * fq);
        float ps[2][4];
#pragma unroll
        for (int ai = 0; ai < 2; ++ai)
#pragma unroll
            for (int m = 0; m < 4; ++m) { float ss = 0.f;
#pragma unroll
                for (int bj = 0; bj < 2; ++bj)
#pragma unroll
                    for (int n = 0; n < 2; ++n) { const f32x4 v = acc[ai][bj][m][n]; ss += (v[0] * v[0] + v[1] * v[1]) + (v[2] * v[2] + v[3] * v[3]); }
                ss += __shfl_xor(ss, 16); ss += __shfl_xor(ss, 32); ps[ai][m] = ss;
                if (fq == 0) xch[(ai * HALF + wr * 64 + m * 16 + fr) * 4 + wc] = ss; }
        asm volatile("s_waitcnt lgkmcnt(0)" ::: "memory"); __builtin_amdgcn_s_barrier(); asm volatile("" ::: "memory");
#pragma unroll
        for (int ai = 0; ai < 2; ++ai)
#pragma unroll
            for (int m = 0; m < 4; ++m) ps[ai][m] += xch[(ai * HALF + wr * 64 + m * 16 + fr) * 4 + (wc ^ 1)];
        const int ldo = isq ? 4096 : 1024;
        bf16_t* B = base + (isq ? (long)pn * BM : SLOT + (long)(pn - 16) * BM) + (size_t)(u.pm * BM + wr * 64 + fr) * ldo + 64 * wc + 16 * fq;
#pragma unroll
        for (int ai = 0; ai < 2; ++ai) {
            const int prow = (4 * u.pm + 2 * ai + wr) & 63;
#pragma unroll
            for (int m = 0; m < 4; ++m) {
                const int pos = w1 ? (16 * m + fr) : prow;
                const float rstd = 1.0f / sqrtf(ps[ai][m] * (1.0f / 128.0f) + 1e-6f);
                f32x4 y[2][2];
#pragma unroll
                for (int bj = 0; bj < 2; ++bj)
#pragma unroll
                    for (int n = 0; n < 2; ++n) y[bj][n] = acc[ai][bj][m][n] * rstd * gg[bj][n];
                if (latent) {
#pragma unroll
                    for (int n = 0; n < 2; ++n) { const float* tp = tab + (pos * 32 + 16 * n + 4 * fq) * 2;
                        const f32x4 A = *(const PG8_GAS f32x4*)tp, Bv = *(const PG8_GAS f32x4*)(tp + 4);
                        const f32x4 c = {A[0], A[2], Bv[0], Bv[2]}, sn = {A[1], A[3], Bv[1], Bv[3]};
                        const f32x4 t1 = y[0][n], t2 = y[1][n]; y[0][n] = t1 * c - t2 * sn; y[1][n] = t1 * sn + t2 * c; }
                }
                bf16_t* rowp = B + (size_t)((ai * HALF + m * 16) * ldo);
#pragma unroll
                for (int bj = 0; bj < 2; ++bj) { const f32x4 v0 = y[bj][0] * osc, v1 = y[bj][1] * osc;
                    u32x4 w; w.x = cvt_pk_bf16(v0[0], v0[1]); w.y = cvt_pk_bf16(v0[2], v0[3]); w.z = cvt_pk_bf16(v1[0], v1[1]); w.w = cvt_pk_bf16(v1[2], v1[3]);
                    *(PG8_GAS u32x4*)(rowp + 8 * bj) = w; }
            }
        }
    }
};
struct EpiConv {
    static constexpr bool PERM = false, AFTER_DRAIN = false;
    bf16_t* U; bf16_t* BZ;
    __device__ __forceinline__ void operator()(const f32x4 (&acc)[2][2][4][2], const Unit& u, int wr, int wc, int fr, int fq) const {
        const int row0 = u.pm * BM + wr * 64 + fr, col0 = u.pn * 64 + wc * 16 + 4 * fq;
#pragma unroll
        for (int ai = 0; ai < 2; ++ai)
#pragma unroll
            for (int m = 0; m < 4; ++m) { const size_t off = (size_t)(row0 + ai * HALF + m * 16) * 4096 + col0;
                const f32x4 bg = acc[ai][0][m][0], cg = acc[ai][0][m][1], xt = acc[ai][1][m][0], z = acc[ai][1][m][1];
                const f32x4 uu = cg * xt; f32x4 bz; bz[0] = bg[0] * silu_f(z[0]); bz[1] = bg[1] * silu_f(z[1]); bz[2] = bg[2] * silu_f(z[2]); bz[3] = bg[3] * silu_f(z[3]);
                u32x2 a; a.x = cvt_pk_bf16(uu[0], uu[1]); a.y = cvt_pk_bf16(uu[2], uu[3]); *(PG8_GAS u32x2*)(U + off) = a;
                u32x2 b; b.x = cvt_pk_bf16(bz[0], bz[1]); b.y = cvt_pk_bf16(bz[2], bz[3]); *(PG8_GAS u32x2*)(BZ + off) = b; }
    }
};
struct EpiResid {
    static constexpr bool PERM = false, AFTER_DRAIN = false;
    const float* xin; float* xout; const float* mod;
    __device__ __forceinline__ void operator()(const f32x4 (&acc)[2][2][4][2], const Unit& u, int wr, int wc, int fr, int fq) const {
        const float* src = xin + (size_t)u.pm * BM * 2048; float* dst = xout + (size_t)u.pm * BM * 2048;
        const float* gate = mod + (u.pm >> 4) * 6144 + 4096;
        const int rl = wr * 64 + fr, col0 = u.pn * BM + wc * 32 + 4 * fq;
        f32x4 gv[2][2];
#pragma unroll
        for (int bj = 0; bj < 2; ++bj)
#pragma unroll
            for (int n = 0; n < 2; ++n) gv[bj][n] = *(const PG8_GAS f32x4*)(gate + col0 + bj * HALF + n * 16);
#pragma unroll
        for (int ai = 0; ai < 2; ++ai)
#pragma unroll
            for (int mp = 0; mp < 2; ++mp) { f32x4 xs[2][2][2];
#pragma unroll
                for (int mm = 0; mm < 2; ++mm) { const size_t off = (size_t)(rl + ai * HALF + (2 * mp + mm) * 16) * 2048 + col0;
#pragma unroll
                    for (int bj = 0; bj < 2; ++bj)
#pragma unroll
                        for (int n = 0; n < 2; ++n) xs[mm][bj][n] = *(const PG8_GAS f32x4*)(src + off + bj * HALF + n * 16); }
#pragma unroll
                for (int mm = 0; mm < 2; ++mm) { const size_t off = (size_t)(rl + ai * HALF + (2 * mp + mm) * 16) * 2048 + col0;
#pragma unroll
                    for (int bj = 0; bj < 2; ++bj)
#pragma unroll
                        for (int n = 0; n < 2; ++n) *(PG8_GAS f32x4*)(dst + off + bj * HALF + n * 16) = xs[mm][bj][n] + gv[bj][n] * acc[ai][bj][2 * mp + mm][n]; }
                asm volatile("" ::: "memory"); }
    }
};
struct EpiSlab {
    static constexpr bool PERM = false, AFTER_DRAIN = false;
    float* slab;
    __device__ __forceinline__ void operator()(const f32x4 (&acc)[2][2][4][2], const Unit& u, int wr, int wc, int fr, int fq) const {
        float* dst = slab + ((size_t)(u.ko >> 9) * 1024 + (size_t)(u.pm - 64) * BM) * 2048;
        const int rl = wr * 64 + fr, col0 = u.pn * BM + wc * 32 + 4 * fq;
#pragma unroll
        for (int ai = 0; ai < 2; ++ai)
#pragma unroll
            for (int m = 0; m < 4; ++m) { const size_t off = (size_t)(rl + ai * HALF + m * 16) * 2048 + col0;
#pragma unroll
                for (int bj = 0; bj < 2; ++bj)
#pragma unroll
                    for (int n = 0; n < 2; ++n) *(PG8_GAS f32x4*)(dst + off + bj * HALF + n * 16) = acc[ai][bj][m][n]; }
    }
};
template <class Epi, class Sched, bool ALIGN_EPI = false, bool SP2 = false>
__device__ __forceinline__ void gemm_phase(PG8_LAS unsigned char* lds, const Gemm g, const Sched& S, const Epi& E) {
    int tid_ = threadIdx.x; asm volatile("" : "+v"(tid_));
    const int tid = tid_, wid = __builtin_amdgcn_readfirstlane(tid >> 6), lane = tid & 63, wr = wid >> 2, wc = wid & 3, fr = lane & 15, fq = lane >> 4;
    const int K = g.K, nt = K / BK, LD = g.ld ? g.ld : g.K;
    unsigned voffA[2], voffB[2];
#pragma unroll
    for (int i = 0; i < 2; ++i) { int R, C; stage_rc(tid * 16 + i * 8192, R, C); const int Rb = Epi::PERM ? ((R & ~31) + perm32(R & 31)) : R;
        voffA[i] = (unsigned)(R * LD + C) * 2u; voffB[i] = (unsigned)(Rb * LD + C) * 2u; }
    const size_t kstep = (size_t)(BK * 2);
    const size_t hstep = (size_t)HALF * LD * 2;
    const size_t tstep = 2 * hstep;
    const unsigned ldsw = (unsigned)wid * 1024u;
    const int aoff = lds_byte(wr * 64 + fr, fq * 8), boff = lds_byte(wc * 32 + fr, fq * 8);
#define PG8_SA(b, h) (((b) * 2 + (h)) * HTB)
#define PG8_SB(b, h) ((4 + (b) * 2 + (h)) * HTB)
#define PG8_STAGE(bufoff, gbase, voff) do { _Pragma("unroll") for (int _i = 0; _i < 2; ++_i) \
        __builtin_amdgcn_global_load_lds((const unsigned*)((const char*)(gbase) + (voff)[_i]), (PG8_LAS unsigned*)(lds + (bufoff) + ldsw + _i * 8192), 16, 0, 0); } while (0)
#define PG8_LDA(dst, b, h) do { _Pragma("unroll") for (int m = 0; m < 4; ++m) _Pragma("unroll") for (int k = 0; k < 2; ++k) dst[m][k] = *(const PG8_LAS bf16x8*)(lds + PG8_SA(b, h) + aoff + m * 2048 + k * 1024); } while (0)
#define PG8_LDB(dst, b, h) do { _Pragma("unroll") for (int n = 0; n < 2; ++n) _Pragma("unroll") for (int k = 0; k < 2; ++k) dst[n][k] = *(const PG8_LAS bf16x8*)(lds + PG8_SB(b, h) + boff + n * 2048 + k * 1024); } while (0)
#define PG8_MMA(ai, bj, At, Bt) do { __builtin_amdgcn_s_setprio(1); _Pragma("unroll") for (int m = 0; m < 4; ++m) _Pragma("unroll") for (int n = 0; n < 2; ++n) _Pragma("unroll") for (int k = 0; k < 2; ++k) \
        acc[ai][bj][m][n] = __builtin_amdgcn_mfma_f32_16x16x32_bf16(Bt[n][k], At[m][k], acc[ai][bj][m][n], 0, 0, 0); __builtin_amdgcn_s_setprio(0); } while (0)
#define PG8_WAIT_V(n) asm volatile("s_waitcnt vmcnt(" #n ")" ::: "memory")
#define PG8_WAIT_L(n) asm volatile("s_waitcnt lgkmcnt(" #n ")" ::: "memory")
#define PG8_BAR __builtin_amdgcn_s_barrier()
#define PG8_SCHED __builtin_amdgcn_sched_barrier(0)
    Unit cur, nxt; int ui = 0;
    if (!S.next(0, cur)) return;
    f32x4 acc[2][2][4][2];
#pragma unroll
    for (int a = 0; a < 2; ++a)
#pragma unroll
        for (int b = 0; b < 2; ++b)
#pragma unroll
            for (int m = 0; m < 4; ++m)
#pragma unroll
                for (int n = 0; n < 2; ++n) acc[a][b][m][n] = (f32x4){0.f, 0.f, 0.f, 0.f};
    bf16x8 At[4][2], B0[2][2], B1[2][2];
    const char* cA = (const char*)g.A + (size_t)cur.pm * tstep + (size_t)cur.ko * 2; const char* cB = (const char*)g.Bt + (size_t)cur.pn * tstep + (size_t)cur.ko * 2;
    S.a_ready(cur);
    if constexpr (SP2) {
        PG8_STAGE(PG8_SB(0, 0), cB, voffB); PG8_STAGE(PG8_SB(0, 1), cB + hstep, voffB); PG8_STAGE(PG8_SA(0, 0), cA, voffA); PG8_STAGE(PG8_SA(0, 1), cA + hstep, voffA);
        if (wr == 1) PG8_BAR;
        PG8_WAIT_V(2); PG8_BAR;
        PG8_STAGE(PG8_SB(1, 0), cB + kstep, voffB); PG8_STAGE(PG8_SA(1, 0), cA + kstep, voffA); PG8_STAGE(PG8_SB(1, 1), cB + hstep + kstep, voffB);
        PG8_WAIT_V(6); PG8_BAR;
    } else {
        PG8_STAGE(PG8_SB(0, 0), cB, voffB); PG8_STAGE(PG8_SA(0, 0), cA, voffA); PG8_STAGE(PG8_SB(0, 1), cB + hstep, voffB); PG8_STAGE(PG8_SA(0, 1), cA + hstep, voffA);
        if (wr == 1) PG8_BAR;
        PG8_WAIT_V(4); PG8_BAR;
        PG8_STAGE(PG8_SB(1, 0), cB + kstep, voffB); PG8_STAGE(PG8_SA(1, 0), cA + kstep, voffA); PG8_STAGE(PG8_SB(1, 1), cB + hstep + kstep, voffB);
        PG8_WAIT_V(6); PG8_BAR;
    }
    for (;;) {
        const bool has_next = S.next(ui + 1, nxt);
        const char* nA = has_next ? (const char*)g.A + (size_t)nxt.pm * tstep + (size_t)nxt.ko * 2 : cA; const char* nB = has_next ? (const char*)g.Bt + (size_t)nxt.pn * tstep + (size_t)nxt.ko * 2 : cB;
        for (int t = 0; t < nt; t += 2) {
            const bool last = (t == nt - 2);
            const char* a1 = cA + (size_t)(t + 1) * kstep;
            const char* a2 = last ? nA : cA + (size_t)(t + 2) * kstep; const char* b2 = last ? nB : cB + (size_t)(t + 2) * kstep;
            const char* a3 = a2 + kstep; const char* b3 = b2 + kstep;
            if (last && has_next) S.a_ready(nxt);
            if constexpr (SP2) {
            PG8_LDB(B0, 0, 0); PG8_LDB(B1, 0, 1); PG8_SCHED; PG8_LDA(At, 0, 0); PG8_STAGE(PG8_SA(1, 1), a1 + hstep, voffA);
            PG8_WAIT_V(8); PG8_WAIT_L(0); PG8_BAR; PG8_MMA(0, 0, At, B0); PG8_MMA(0, 1, At, B1); PG8_BAR; PG8_SCHED;
            PG8_LDA(At, 0, 1); PG8_STAGE(PG8_SB(0, 0), b2, voffB); PG8_STAGE(PG8_SB(0, 1), b2 + hstep, voffB); PG8_STAGE(PG8_SA(0, 0), a2, voffA);
            PG8_WAIT_V(8); PG8_WAIT_L(0); PG8_BAR; PG8_MMA(1, 0, At, B0); PG8_MMA(1, 1, At, B1); PG8_BAR; PG8_SCHED;
            PG8_LDB(B0, 1, 0); PG8_LDB(B1, 1, 1); PG8_SCHED; PG8_LDA(At, 1, 0); PG8_STAGE(PG8_SA(0, 1), a2 + hstep, voffA);
            PG8_WAIT_V(8); PG8_WAIT_L(0); PG8_BAR; PG8_MMA(0, 0, At, B0); PG8_MMA(0, 1, At, B1); PG8_BAR; PG8_SCHED;
            PG8_LDA(At, 1, 1); PG8_STAGE(PG8_SB(1, 0), b3, voffB); PG8_STAGE(PG8_SB(1, 1), b3 + hstep, voffB); PG8_STAGE(PG8_SA(1, 0), a3, voffA);
            PG8_WAIT_V(8); PG8_WAIT_L(0); PG8_BAR; PG8_MMA(1, 0, At, B0); PG8_MMA(1, 1, At, B1); PG8_BAR; PG8_SCHED;
            } else {
            PG8_LDB(B0, 0, 0); PG8_SCHED; PG8_LDA(At, 0, 0); PG8_STAGE(PG8_SA(1, 1), a1 + hstep, voffA);
            PG8_WAIT_L(8); PG8_BAR; PG8_WAIT_L(0); PG8_MMA(0, 0, At, B0); PG8_BAR; PG8_SCHED;
            PG8_LDB(B1, 0, 1); PG8_STAGE(PG8_SB(0, 0), b2, voffB);
            PG8_BAR; PG8_WAIT_L(0); PG8_MMA(0, 1, At, B1); PG8_BAR;
            PG8_LDA(At, 0, 1); PG8_STAGE(PG8_SA(0, 0), a2, voffA);
            PG8_BAR; PG8_WAIT_L(0); PG8_MMA(1, 0, At, B0); PG8_BAR; PG8_SCHED;
            PG8_STAGE(PG8_SB(0, 1), b2 + hstep, voffB);
            PG8_WAIT_V(6); PG8_BAR; PG8_MMA(1, 1, At, B1); PG8_BAR;
            PG8_LDB(B0, 1, 0); PG8_SCHED; PG8_LDA(At, 1, 0); PG8_STAGE(PG8_SA(0, 1), a2 + hstep, voffA);
            PG8_WAIT_L(8); PG8_BAR; PG8_WAIT_L(0); PG8_MMA(0, 0, At, B0); PG8_BAR; PG8_SCHED;
            PG8_LDB(B1, 1, 1); PG8_STAGE(PG8_SB(1, 0), b3, voffB);
            PG8_BAR; PG8_WAIT_L(0); PG8_MMA(0, 1, At, B1); PG8_BAR;
            PG8_LDA(At, 1, 1); PG8_STAGE(PG8_SA(1, 0), a3, voffA);
            PG8_BAR; PG8_WAIT_L(0); PG8_MMA(1, 0, At, B0); PG8_BAR; PG8_SCHED;
            PG8_STAGE(PG8_SB(1, 1), b3 + hstep, voffB);
            PG8_WAIT_V(6); PG8_BAR; PG8_MMA(1, 1, At, B1); PG8_BAR;
            }
        }
        if constexpr (ALIGN_EPI) { if (wr == 0) PG8_BAR; }
        if constexpr (!Epi::AFTER_DRAIN) { E(acc, cur, wr, wc, fr, fq); S.done(cur); }
        if (!has_next) break;
#pragma unroll
        for (int a = 0; a < 2; ++a)
#pragma unroll
            for (int b = 0; b < 2; ++b)
#pragma unroll
                for (int m = 0; m < 4; ++m)
#pragma unroll
                    for (int n = 0; n < 2; ++n) acc[a][b][m][n] = (f32x4){0.f, 0.f, 0.f, 0.f};
        cur = nxt; cA = nA; cB = nB; ++ui;
        if constexpr (ALIGN_EPI) { if (wr == 1) PG8_BAR; }
    }
    PG8_WAIT_V(0);
    if constexpr (!ALIGN_EPI) { if (wr == 0) PG8_BAR; }
    PG8_BAR;
    if constexpr (Epi::AFTER_DRAIN) { E.fused(acc, cur, wr, wc, fr, fq, lds, wid, lane); S.done(cur); }
#undef PG8_SA
#undef PG8_SB
#undef PG8_STAGE
#undef PG8_LDA
#undef PG8_LDB
#undef PG8_MMA
#undef PG8_WAIT_V
#undef PG8_WAIT_L
#undef PG8_BAR
#undef PG8_SCHED
}
}
namespace cg = cooperative_groups;
#define LAS __attribute__((address_space(3)))
#define GAS __attribute__((address_space(1)))
typedef unsigned short bf16;
typedef unsigned v4u __attribute__((ext_vector_type(4)));
typedef unsigned v2u __attribute__((ext_vector_type(2)));
typedef float f32x4 __attribute__((ext_vector_type(4)));
typedef float f32x16 __attribute__((ext_vector_type(16)));
typedef short bf16x8 __attribute__((ext_vector_type(8)));
typedef short s16x4 __attribute__((ext_vector_type(4)));
typedef float f32x2_t __attribute__((ext_vector_type(2)));
typedef __bf16 bf16x2_t __attribute__((ext_vector_type(2)));

constexpr int DM = 2048, DI = 4096, SEQ = 4096, ML = 16384, MC = 1024, MT = ML + MC;
constexpr float EPS = 1e-6f, LOG2E = 1.4426950408889634f;
constexpr float LAM_INIT1 = 0.35550906f;
constexpr int NWAVES = 8, NPH = 21;
constexpr int LDS_BYTES = 147456, LDS_BARST = LDS_BYTES - 64;

constexpr size_t MiB = 1u << 20;
constexpr size_t WS_MOD = 0, MOD_ZERO_BYTES = 512 * 1024;
constexpr size_t WS_BAR = 496 * 1024;
constexpr size_t WS_TAB = 1 * MiB;
constexpr size_t WS_WTIN = 2 * MiB, WS_WTOUT = 66 * MiB;
constexpr size_t WS_HA = 82 * MiB;
constexpr size_t WS_CBUF = 150 * MiB;
constexpr size_t WS_SLOT = 160 * MiB, SLOT_BYTES = 136 * MiB;
constexpr size_t WS_SLAB = WS_SLOT + 4 * SLOT_BYTES;
constexpr size_t WS_END = WS_SLAB + 64 * MiB;

__device__ __forceinline__ unsigned f2bf(float f) { unsigned u = __builtin_bit_cast(unsigned, f); return (u + 0x7fffu + ((u >> 16) & 1u)) >> 16; }
__device__ __forceinline__ unsigned pk2(float lo, float hi) { f32x2_t v = {lo, hi}; bf16x2_t b = __builtin_convertvector(v, bf16x2_t); return __builtin_bit_cast(unsigned, b); }
__device__ __forceinline__ float bflo(unsigned w) { return __builtin_bit_cast(float, w << 16); }
__device__ __forceinline__ float bfhi(unsigned w) { return __builtin_bit_cast(float, w & 0xffff0000u); }
__device__ __forceinline__ float wave_sum(float v) {
#pragma unroll
    for (int o = 1; o < 64; o <<= 1) v += __shfl_xor(v, o);
    return v;
}
__device__ __forceinline__ float wave_max(float v) {
#pragma unroll
    for (int o = 1; o < 64; o <<= 1) v = fmaxf(v, __shfl_xor(v, o));
    return v;
}
#define LDS_WAIT() asm volatile("s_waitcnt lgkmcnt(0)" ::: "memory")
__device__ __forceinline__ int crow(int r, int hi) { return (r & 3) + 8 * (r >> 2) + 4 * hi; }

enum { MAP_ID = 0, MAP_P32 = 1, MAP_CONV = 2, MAP_DIFF = 3, MAP_WIN = 4 };
template <int MAP> __device__ __forceinline__ int colmap(int slot) {
    if (MAP == MAP_ID) return slot;
    if (MAP == MAP_P32) return (slot & ~31) + pg8::perm32(slot & 31);
    const int pn = slot >> 8, s = slot & 255, bj = s >> 7, wc = (s >> 5) & 3, n = (s >> 4) & 1, q = s & 15;
    if (MAP == MAP_WIN) return pn < 20 ? pn * 256 + 64 * wc + 32 * bj + 16 * n + q : (slot & ~31) + pg8::perm32(slot & 31);
    if (MAP == MAP_DIFF) return pn < 32 ? pn * 256 + 64 * wc + 32 * bj + 16 * n + q : (slot & ~31) + pg8::perm32(slot & 31);
    return (2 * bj + n) * 4096 + 64 * pn + 16 * wc + q;
}
template <int MAP> __device__ __forceinline__ void transpose_item(const float* W, int K, int N, bf16* WT, LAS float* scr, int item, int lane) {
    const int nblk = N / 32, kb = item / nblk, nb = item % nblk, k0 = 64 * kb, n0 = 32 * nb;
    const int col = colmap<MAP>(n0 + (lane & 31));
    float tv[32];
#pragma unroll
    for (int i = 0; i < 32; ++i) { const int kk = 2 * i + (lane >> 5); tv[i] = ((const GAS float*)W)[(size_t)(k0 + kk) * N + col]; }
#pragma unroll
    for (int i = 0; i < 32; ++i) { const int kk = 2 * i + (lane >> 5); scr[kk * 33 + (lane & 31)] = tv[i]; }
    LDS_WAIT();
    const int c = lane & 7;
#pragma unroll
    for (int j = 0; j < 4; ++j) { const int n = (lane >> 3) + 8 * j; const LAS float* s = scr + (8 * c) * 33 + n;
        v4u o; o.x = pk2(s[0 * 33], s[1 * 33]); o.y = pk2(s[2 * 33], s[3 * 33]); o.z = pk2(s[4 * 33], s[5 * 33]); o.w = pk2(s[6 * 33], s[7 * 33]);
        *(GAS v4u*)(WT + (size_t)(n0 + n) * K + k0 + 8 * c) = o; }
    LDS_WAIT();
}
template <int MAP> __device__ __forceinline__ void transpose_all(const float* W, int K, int N, bf16* WT, LAS float* scr, int gw, int NGW, int lane) {
    const int items = (K / 64) * (N / 32);
    for (int it = gw; it < items; it += NGW) transpose_item<MAP>(W, K, N, WT, scr, it, lane);
}

struct Args { const float* in[38]; float* out; unsigned char* ws; int ph_lo, ph_hi; };
__device__ __forceinline__ const float* argp(int i) { const char* k = (const char*)__builtin_amdgcn_kernarg_segment_ptr(); asm volatile("" : "+s"(k)); const float* p = *(const float* const*)(k + 8 * i); return (const float*)(const GAS float*)p; }

__device__ __forceinline__ void mod_item(float* mod, LAS float* scr, int it, int lane) {
    const int l = it / 1536, r = it % 1536, kc = r / 96, cb = r % 96, k0 = kc * 128, col = cb * 64 + lane;
    const float* Wm = argp(l == 0 ? 5 : l == 1 ? 12 : l == 2 ? 24 : 32);
    const float* bm = argp(l == 0 ? 6 : l == 1 ? 13 : l == 2 ? 25 : 33);
    const float* c = argp(1); const float* cc = argp(3);
#pragma unroll
    for (int j = 0; j < 2; ++j) { const int kk = lane + 64 * j;
#pragma unroll
        for (int bi = 0; bi < 5; ++bi) { const float cv = bi < 4 ? c[bi * 2048 + k0 + kk] : cc[k0 + kk]; scr[bi * 128 + kk] = cv / (1.0f + __expf(-cv)); } }
    LDS_WAIT();
    float acc[5] = {0.f, 0.f, 0.f, 0.f, 0.f};
    const float* wp = Wm + (size_t)k0 * 6144 + col;
#pragma unroll 32
    for (int kk = 0; kk < 128; ++kk) { const float w = ((const GAS float*)wp)[(size_t)kk * 6144];
#pragma unroll
        for (int bi = 0; bi < 5; ++bi) acc[bi] += scr[bi * 128 + kk] * w; }
    if (kc == 0) { const float b = bm[col];
#pragma unroll
        for (int bi = 0; bi < 5; ++bi) acc[bi] += b; }
#pragma unroll
    for (int bi = 0; bi < 5; ++bi) atomicAdd(mod + (size_t)(l * 5 + bi) * 6144 + col, acc[bi]);
    LDS_WAIT();
}

__device__ __forceinline__ void norm_row(const float* src, const float* g, const float* md, bf16* dst, int lane, const float* slab = nullptr, const float* gate = nullptr, float* upd = nullptr) {
    const GAS f32x4* xr = (const GAS f32x4*)src + lane;
    f32x4 v[8]; float s = 0.f;
#pragma unroll
    for (int j = 0; j < 8; ++j) v[j] = xr[64 * j];
    if (slab) {
#pragma unroll
        for (int j = 0; j < 8; ++j) { f32x4 a = {0.f, 0.f, 0.f, 0.f};
#pragma unroll
            for (int ks = 0; ks < 8; ++ks) a += *((const GAS f32x4*)(slab + (size_t)ks * 1024 * 2048) + 64 * j + lane);
            v[j] += a * *((const GAS f32x4*)gate + 64 * j + lane); *((GAS f32x4*)upd + 64 * j + lane) = v[j]; }
    }
#pragma unroll
    for (int j = 0; j < 8; ++j) s += (v[j].x * v[j].x + v[j].y * v[j].y) + (v[j].z * v[j].z + v[j].w * v[j].w);
    const float rstd = 1.0f / sqrtf(wave_sum(s) * (1.0f / 2048.0f) + EPS);
#pragma unroll
    for (int j = 0; j < 8; ++j) { const int col = 256 * j + 4 * lane;
        const f32x4 g4 = *(const GAS f32x4*)(g + col), sh = *(const GAS f32x4*)(md + col), sc = *(const GAS f32x4*)(md + 2048 + col);
        const f32x4 y = (v[j] * rstd) * g4 * (sc + 1.0f) + sh;
        v2u o; o.x = pk2(y.x, y.y); o.y = pk2(y.z, y.w); *(GAS v2u*)(dst + col) = o; }
}

__device__ __forceinline__ void conv_item(const bf16* U, const bf16* BZ, bf16* Gd, const float* cw, const float* cb, int item, int tid) {
    const int r0 = 16 * item, col = 8 * tid;
    int s0, s1; if (r0 < ML) { s0 = r0 & ~4095; s1 = s0 + 4096; } else { s0 = ML + ((r0 - ML) & ~255); s1 = s0 + 256; }
    float w0[8], w1[8], w2[8], bb[8];
#pragma unroll
    for (int h = 0; h < 2; ++h) { const f32x4 a = *(const f32x4*)(cw + col + 4 * h), b = *(const f32x4*)(cw + 4096 + col + 4 * h), c = *(const f32x4*)(cw + 8192 + col + 4 * h), d = *(const f32x4*)(cb + col + 4 * h);
#pragma unroll
        for (int e = 0; e < 4; ++e) { w0[4 * h + e] = a[e]; w1[4 * h + e] = b[e]; w2[4 * h + e] = c[e]; bb[4 * h + e] = d[e]; } }
    const v4u zero = {0u, 0u, 0u, 0u};
    v4u prev = (r0 > s0) ? *(const GAS v4u*)(U + (size_t)(r0 - 1) * 4096 + col) : zero;
    v4u cur = *(const GAS v4u*)(U + (size_t)r0 * 4096 + col);
#pragma unroll 4
    for (int i = 0; i < 16; ++i) { const int r = r0 + i;
        const v4u nxt = (r + 1 < s1) ? *(const GAS v4u*)(U + (size_t)(r + 1) * 4096 + col) : zero;
        const v4u bz = *(const GAS v4u*)(BZ + (size_t)r * 4096 + col);
        v4u o;
#pragma unroll
        for (int w = 0; w < 4; ++w) {
            const float y0 = w0[2 * w] * bflo(prev[w]) + w1[2 * w] * bflo(cur[w]) + w2[2 * w] * bflo(nxt[w]) + bb[2 * w];
            const float y1 = w0[2 * w + 1] * bfhi(prev[w]) + w1[2 * w + 1] * bfhi(cur[w]) + w2[2 * w + 1] * bfhi(nxt[w]) + bb[2 * w + 1];
            o[w] = pk2(bflo(bz[w]) * y0, bfhi(bz[w]) * y1); }
        *(GAS v4u*)(Gd + (size_t)r * 4096 + col) = o;
        prev = cur; cur = nxt; }
}

template <int HD> __device__ __forceinline__ void qknorm_item(bf16* X, int ld, int item, const v4u raw, const float* gain, float oscale, const float2* tab, int lane) {
    constexpr int LPH = HD / 8, NF = HD / 4;
    const int parts = ld / 512, row = item / parts, part = item % parts, col = (part * 64 + lane) * 8, d0 = col % HD;
    bf16* p = X + (size_t)row * ld + col;
    float v[8];
#pragma unroll
    for (int w = 0; w < 4; ++w) { v[2 * w] = bflo(raw[w]); v[2 * w + 1] = bfhi(raw[w]); }
    float ss = 0.f;
#pragma unroll
    for (int e = 0; e < 8; ++e) ss += v[e] * v[e];
#pragma unroll
    for (int o = 1; o < LPH; o <<= 1) ss += __shfl_xor(ss, o);
    const float rstd = 1.0f / sqrtf(ss * (1.0f / HD) + EPS);
#pragma unroll
    for (int e = 0; e < 8; ++e) v[e] = v[e] * rstd * gain[d0 + e];
    float pv[8];
#pragma unroll
    for (int e = 0; e < 8; ++e) pv[e] = __shfl_xor(v[e], LPH / 4);
    if (row < ML) {
        const int t = row & 4095, axis = d0 / (HD / 2), half = (d0 / NF) & 1, f0 = d0 % NF, pos = axis ? (t & 63) : (t >> 6);
        const float2* cs = tab + pos * NF + f0;
#pragma unroll
        for (int e = 0; e < 8; ++e) { const float2 c = cs[e]; v[e] = half ? (pv[e] * c.y + v[e] * c.x) : (v[e] * c.x - pv[e] * c.y); }
    }
    v4u o;
#pragma unroll
    for (int w = 0; w < 4; ++w) o[w] = pk2(v[2 * w] * oscale, v[2 * w + 1] * oscale);
    *(GAS v4u*)p = o;
}
template <int HD> __device__ __forceinline__ void qknorm_all(bf16* X, int ld, int nitems, const float* gain, float oscale, const float2* tab, int gw, int NGW, int lane) {
    const int parts = ld / 512;
    for (int it = gw * 4; it < nitems; it += NGW * 4) {
        v4u raw[4];
#pragma unroll
        for (int j = 0; j < 4; ++j) { const int item = it + j, row = item / parts, part = item % parts; raw[j] = *(const GAS v4u*)(X + (size_t)row * ld + (part * 64 + lane) * 8); }
#pragma unroll
        for (int j = 0; j < 4; ++j) qknorm_item<HD>(X, ld, it + j, raw[j], gain, oscale, tab, lane);
    }
}

__device__ __forceinline__ s16x4 vtr(const LAS unsigned char* p) { typedef short v4i16_t __attribute__((ext_vector_type(4))); return __builtin_bit_cast(s16x4, __builtin_amdgcn_ds_read_tr16_b64_v4i16((LAS v4i16_t*)p)); }
template <bool DIFF, int VAR = 0>
__device__ __forceinline__ void attn_phase(LAS unsigned char* lds, const bf16* Q, bf16* O, const bf16* K, const bf16* V, const bf16* Z, const int ldk,
                                           const float shift2, const float lam, const float* subnorm, const float* sink, const float oscale, const int G, const int vcu) {
    int tid_ = threadIdx.x; asm volatile("" : "+v"(tid_));
    const int tid = tid_, lane = tid & 63, wid = __builtin_amdgcn_readfirstlane(tid >> 6), r32 = lane & 31, hi = lane >> 5;
    constexpr int KSTR = 272, VSTR = 320, KBYTES = 64 * KSTR, STAGE = KBYTES + 64 * VSTR, XOFF = 0, WSOFF = 3 * STAGE;
    static_assert(WSOFF + 8 * 128 <= LDS_BARST && 65536 <= 3 * STAGE, "attention LDS map");
    constexpr int DSTEPS = DIFF ? 4 : 8;
    const int nunits = DIFF ? 128 * 34 : 2048;
    const int skey = tid >> 4, scc = tid & 15;
    LAS float* wsf = (LAS float*)(lds + WSOFF) + wid * 32;
    const int vrow = 4 * hi + ((lane & 15) >> 2), vcol = 16 * ((lane >> 4) & 1) + 4 * (lane & 3);
    for (int u = vcu, ui = 0; u < nunits; u += G, ++ui) {
        int nlat, lat0, ctx0, koff, myq0, qcol0, kd0, zcol0, kt0 = 0, qpos = 0, qb_ = 0; float sinkv = 0.f;
        if (DIFF) {
            int bh, qi; if (u < 4096) { bh = u >> 5; qi = u & 31; } else { bh = (u - 4096) >> 1; qi = 32 + ((u - 4096) & 1); }
            const int b = bh >> 5, h = bh & 31, m = wid >> 2, qs = wid & 3; (void)ui;
            int qrow0; if (qi < 32) { qrow0 = b * 4096 + 128 * qi; nlat = 64; } else { qrow0 = ML + b * 256 + 128 * (qi - 32); nlat = 0; }
            lat0 = b * 4096; ctx0 = ML + b * 256; koff = h * 128; myq0 = qrow0 + 32 * qs; qcol0 = h * 128 + 64 * m; kd0 = 64 * m; zcol0 = h * 128;
        } else {
            const int b = u >> 9, kvh = (u >> 6) & 7, qb = u & 63, g = wid >> 1, qs = wid & 1, head = kvh * 4 + g;
            kt0 = qb - 2 < 0 ? 0 : qb - 2; const int kt1 = qb + 2 > 63 ? 63 : qb + 2; nlat = kt1 - kt0 + 1;
            lat0 = b * 4096 + 64 * kt0; ctx0 = ML + b * 256; koff = kvh * 128; myq0 = b * 4096 + 64 * qb + 32 * qs; qcol0 = head * 128; kd0 = 0; zcol0 = head * 128;
            qpos = 64 * qb + 32 * qs + r32; sinkv = sink[head]; qb_ = qb;
        }
        const int nt = nlat + 4;
        bf16x8 qf[DSTEPS];
#pragma unroll
        for (int d = 0; d < DSTEPS; ++d) qf[d] = *(const GAS bf16x8*)(Q + (size_t)(myq0 + r32) * 4096 + qcol0 + 16 * d + 8 * hi);
        f32x16 o[4];
#pragma unroll
        for (int e = 0; e < 4; ++e)
#pragma unroll
            for (int r = 0; r < 16; ++r) o[e][r] = 0.f;
        float lsum = 0.f;
        v4u kreg[2], vreg[2];
#define ATT_TROW(tt) (((tt) < nlat) ? lat0 + 64 * (tt) : ctx0 + 64 * ((tt) - nlat))
#define ATT_LOAD(tt) do { const int r0_ = ATT_TROW(tt); _Pragma("unroll") for (int i = 0; i < 2; ++i) { const size_t go = (size_t)(r0_ + skey + 32 * i) * ldk + koff + 8 * scc; kreg[i] = *(const GAS v4u*)(K + go); vreg[i] = *(const GAS v4u*)(V + go); } } while (0)
#define ATT_WRITE(so) do { _Pragma("unroll") for (int i = 0; i < 2; ++i) { *(LAS v4u*)(lds + (so) + (skey + 32 * i) * KSTR + scc * 16) = kreg[i]; *(LAS v4u*)(lds + (so) + KBYTES + (skey + 32 * i) * VSTR + scc * 16) = vreg[i]; } } while (0)
#define ATT_QK(S0_, S1_, so) do { const LAS unsigned char* kp_ = lds + (so) + r32 * KSTR + (kd0 + 8 * hi) * 2; \
            _Pragma("unroll") for (int r = 0; r < 16; ++r) { S0_[r] = -shift2; S1_[r] = -shift2; } \
            _Pragma("unroll") for (int d = 0; d < DSTEPS; ++d) { const bf16x8 k0_ = *(const LAS bf16x8*)(kp_ + d * 32), k1_ = *(const LAS bf16x8*)(kp_ + 32 * KSTR + d * 32); \
                S0_ = __builtin_amdgcn_mfma_f32_32x32x16_bf16(k0_, qf[d], S0_, 0, 0, 0); S1_ = __builtin_amdgcn_mfma_f32_32x32x16_bf16(k1_, qf[d], S1_, 0, 0, 0); \
                } } while (0)
        ATT_LOAD(0); ATT_WRITE(0); ATT_LOAD(1); ATT_WRITE(STAGE); ATT_LOAD(2);
        __syncthreads();
        f32x16 s0, s1, n0, n1;
        constexpr bool PIPE = DIFF;
        if (PIPE) ATT_QK(s0, s1, 0);
        int so_c = 0, so_n = STAGE, so_w = 2 * STAGE;
        for (int t = 0; t < nt; ++t) {
            if (VAR != 2) { ATT_WRITE(so_w); const int tl = t + 3 < nt ? t + 3 : nt - 1; ATT_LOAD(tl); } __builtin_amdgcn_sched_barrier(0);
            if (PIPE) { const int so_q = t + 1 < nt ? so_n : so_c; ATT_QK(n0, n1, so_q); }
            else ATT_QK(s0, s1, so_c);
#pragma unroll
            for (int r = 0; r < 16; ++r) { if (VAR == 1) { s0[r] = s0[r] * 1.0001f + 0.5f; s1[r] = s1[r] * 1.0001f + 0.5f; } else { s0[r] = __builtin_amdgcn_exp2f(s0[r]); s1[r] = __builtin_amdgcn_exp2f(s1[r]); } }
            if (!DIFF && t < nlat && (kt0 + t == qb_ - 2 || kt0 + t == qb_ + 2)) { const int lim = 128; const int kb0 = 64 * (kt0 + t) - qpos;
#pragma unroll
                for (int r = 0; r < 16; ++r) { const int dd = kb0 + crow(r, hi); if (dd < -lim || dd > lim) s0[r] = 0.f; if (dd + 32 < -lim || dd + 32 > lim) s1[r] = 0.f; } }
            { float a = 0.f, b = 0.f;
#pragma unroll
              for (int r = 0; r < 16; ++r) { a += s0[r]; b += s1[r]; }
              lsum += a + b; }
            const LAS unsigned char* vp = lds + so_c + KBYTES + vrow * VSTR + vcol * 2;
#pragma unroll
            for (int kb = 0; kb < 2; ++kb)
#pragma unroll
                for (int sp = 0; sp < 2; ++sp) {
                    v4u pw;
#pragma unroll
                    for (int w = 0; w < 4; ++w) pw[w] = kb == 0 ? pk2(s0[8 * sp + 2 * w], s0[8 * sp + 2 * w + 1]) : pk2(s1[8 * sp + 2 * w], s1[8 * sp + 2 * w + 1]);
                    const bf16x8 pa = __builtin_bit_cast(bf16x8, pw);
#pragma unroll
                    for (int eb = 0; eb < 4; ++eb) {
                        bf16x8 vb;
                        if (VAR == 3) { vb = qf[(kb * 2 + sp + eb) & 3]; }
                        else { const s16x4 lo = vtr(vp + (32 * kb + 16 * sp) * VSTR + 64 * eb), hh = vtr(vp + (32 * kb + 16 * sp + 8) * VSTR + 64 * eb);
                        vb = (bf16x8){lo[0], lo[1], lo[2], lo[3], hh[0], hh[1], hh[2], hh[3]}; }
                        o[eb] = __builtin_amdgcn_mfma_f32_32x32x16_bf16(pa, vb, o[eb], 0, 0, 0); } }
            if (VAR != 4) __syncthreads();
            if (PIPE) { s0 = n0; s1 = n1; }
            { const int tmp = so_c; so_c = so_n; so_n = so_w; so_w = tmp; }
        }
#undef ATT_TROW
#undef ATT_LOAD
#undef ATT_WRITE
#undef ATT_QK
        float lt = lsum + __shfl_xor(lsum, 32);
        if (!DIFF) lt += __builtin_amdgcn_exp2f(sinkv * LOG2E - shift2);
        if (hi == 0) wsf[r32] = lt;
        LDS_WAIT();
        float rl[16];
#pragma unroll
        for (int r = 0; r < 16; ++r) rl[r] = 1.0f / wsf[crow(r, hi)];
        LDS_WAIT();
        if (DIFF) {
            LAS float* X = (LAS float*)(lds + XOFF) + (wid & 3) * 4096 + lane;
            if (wid >= 4) {
#pragma unroll
                for (int eb = 0; eb < 4; ++eb)
#pragma unroll
                    for (int r = 0; r < 16; ++r) X[(eb * 16 + r) * 64] = o[eb][r] * rl[r] * lam;
            }
            __syncthreads();
            if (wid < 4) {
                float ssq[16];
#pragma unroll
                for (int r = 0; r < 16; ++r) ssq[r] = 0.f;
#pragma unroll
                for (int eb = 0; eb < 4; ++eb)
#pragma unroll
                    for (int r = 0; r < 16; ++r) { const float v = o[eb][r] * rl[r] - X[(eb * 16 + r) * 64]; o[eb][r] = v; ssq[r] += v * v; }
#pragma unroll
                for (int r = 0; r < 16; ++r) { float s = ssq[r];
#pragma unroll
                    for (int of = 1; of < 32; of <<= 1) s += __shfl_xor(s, of);
                    ssq[r] = oscale / sqrtf(s * (1.0f / 128.0f) + EPS); }
#pragma unroll
                for (int eb = 0; eb < 4; ++eb) { const float gn = subnorm[32 * eb + r32];
                    unsigned zz[16];
#pragma unroll
                    for (int r = 0; r < 16; ++r) zz[r] = (unsigned)((const GAS bf16*)Z)[(size_t)(myq0 + crow(r, hi)) * 4096 + zcol0 + 32 * eb + r32];
#pragma unroll
                    for (int r = 0; r < 16; ++r) { const size_t off = (size_t)(myq0 + crow(r, hi)) * 4096 + zcol0 + 32 * eb + r32;
                        ((GAS bf16*)O)[off] = (bf16)f2bf(o[eb][r] * ssq[r] * gn * pg8::silu_f(bflo(zz[r]))); } }
            }
            __syncthreads();
        } else {
#pragma unroll
            for (int eb = 0; eb < 4; ++eb) { unsigned zz[16];
#pragma unroll
                for (int r = 0; r < 16; ++r) zz[r] = (unsigned)((const GAS bf16*)Z)[(size_t)(myq0 + crow(r, hi)) * 4096 + zcol0 + 32 * eb + r32];
#pragma unroll
                for (int r = 0; r < 16; ++r) { const size_t off = (size_t)(myq0 + crow(r, hi)) * 4096 + zcol0 + 32 * eb + r32;
                    ((GAS bf16*)O)[off] = (bf16)f2bf(o[eb][r] * rl[r] * pg8::silu_f(bflo(zz[r]))); } }
        }
    }
}

#define RLX_AGENT __ATOMIC_RELAXED, __HIP_MEMORY_SCOPE_AGENT
#define XB_TMO      128
#define XB_XCNT(j)  (256  + 64 * (j))
#define XB_XSUB(j)  (1280 + 64 * (j))
#define XB_XGEN(j)  (2304 + 64 * (j))
#define XB_TOP      3328
#define XB_TOPGEN   3392
#define XCD_BAR_WORDS 3456
#define XB_SPIN_CAP (1u << 18)

__device__ __forceinline__ unsigned xb_ld(unsigned* p)              { return __hip_atomic_load(p, __ATOMIC_RELAXED, __HIP_MEMORY_SCOPE_AGENT); }
__device__ __forceinline__ unsigned xb_add(unsigned* p, unsigned v) { return __hip_atomic_fetch_add(p, v, __ATOMIC_RELAXED, __HIP_MEMORY_SCOPE_AGENT); }
__device__ __forceinline__ unsigned xb_xcc_id() { return (unsigned)__builtin_amdgcn_s_getreg((3 << 11) | 20) & 0xFu; }
#define XB_SPIN(cond, bar) do { unsigned _sp = 0; while (cond) { __builtin_amdgcn_s_sleep(1); \
    if ((++_sp & 255u) == 0u) { if (xb_ld(&(bar)[XB_TMO])) break; if (_sp > XB_SPIN_CAP) { atomicAdd(&(bar)[XB_TMO], 1u); break; } } } } while (0)

struct XcdBarrier {
    unsigned* bar; unsigned x;
    volatile LAS unsigned* st;
};

__device__ __forceinline__ XcdBarrier xcd_barrier_post(unsigned* bar, volatile LAS unsigned* st) {
    XcdBarrier b; b.bar = bar; b.x = xb_xcc_id(); b.st = st;
    if (threadIdx.x == 0) (void)xb_add(&bar[XB_XCNT(b.x)], 1u);
    return b;
}
__device__ __forceinline__ void xcd_barrier_complete(unsigned* bar, unsigned x, unsigned& nloc, unsigned& nx) {
    const unsigned G = gridDim.x * gridDim.y * gridDim.z;
    unsigned sum, cnt, mine, sp = 0u;
    for (;;) {
        sum = 0u; cnt = 0u; mine = 0u;
#pragma unroll
        for (unsigned j = 0; j < 16; ++j) { const unsigned c = xb_ld(&bar[XB_XCNT(j)]); sum += c; cnt += (c > 0u) ? 1u : 0u; mine = (j == x) ? c : mine; }
        if (sum == G) break;
        __builtin_amdgcn_s_sleep(1);
        if ((++sp & 255u) == 0u) { if (xb_ld(&bar[XB_TMO])) break; if (sp > XB_SPIN_CAP) { atomicAdd(&bar[XB_TMO], 1u); break; } }
    }
    nloc = mine > 0u ? mine : 1u; nx = cnt > 0u ? cnt : 1u;
}

__device__ __forceinline__ void xcd_barrier(const XcdBarrier& b) {
    asm volatile("s_waitcnt vmcnt(0)" ::: "memory");
    __syncthreads();
    if (threadIdx.x == 0) {
        unsigned* bar = b.bar;
        __builtin_amdgcn_s_waitcnt(0);
        unsigned nloc = b.st[0], nx = b.st[1];
        if (nloc == 0u) { xcd_barrier_complete(bar, b.x, nloc, nx); b.st[0] = nloc; b.st[1] = nx; }
        const unsigned old = xb_add(&bar[XB_XSUB(b.x)], 1u);
        const unsigned gen = old / nloc;
        if (old + 1u == (gen + 1u) * nloc) {
            __builtin_amdgcn_fence(__ATOMIC_RELEASE, "agent");
            asm volatile("s_waitcnt vmcnt(0)" ::: "memory");
            const unsigned og = xb_add(&bar[XB_TOP], 1u);
            const unsigned tg = og / nx;
            if (og + 1u == (tg + 1u) * nx) xb_add(&bar[XB_TOPGEN], 1u);
            else XB_SPIN(xb_ld(&bar[XB_TOPGEN]) == tg, bar);
            __builtin_amdgcn_fence(__ATOMIC_ACQUIRE, "agent");
            xb_add(&bar[XB_XGEN(b.x)], 1u);
            asm volatile("s_waitcnt vmcnt(0)" ::: "memory");
        } else {
            XB_SPIN(xb_ld(&bar[XB_XGEN(b.x)]) == gen, bar);
            __builtin_amdgcn_fence(__ATOMIC_ACQUIRE, "agent");
            asm volatile("s_waitcnt vmcnt(0)" ::: "memory");
        }
    }
    __syncthreads();
}

#ifndef G2_ALIGN
#define G2_ALIGN false
#endif
#ifndef MK_SINGLE
#define MK_SINGLE 1
#endif
__global__ void __launch_bounds__(NWAVES * 64, 2) mk_fwd(Args a) {
    extern __shared__ __attribute__((aligned(16))) unsigned char lds_raw[];
    LAS unsigned char* lds = (LAS unsigned char*)lds_raw;
    cg::grid_group grid = cg::this_grid();
    const int lo = a.ph_lo, hi = a.ph_hi;
#define PHASE_LOCALS \
    int tid_ = threadIdx.x; asm volatile("" : "+v"(tid_)); const int tid = tid_, lane = tid & 63, wave = __builtin_amdgcn_readfirstlane(tid >> 6); (void)lane; (void)wave; \
    int G_ = gridDim.x, bx_ = blockIdx.x; asm volatile("" : "+s"(G_), "+s"(bx_)); const int G = G_, bx = bx_, vcu = (G % 8 == 0) ? (bx % 8) * (G / 8) + bx / 8 : bx; \
    const int gw = vcu * NWAVES + wave, NGW = G * NWAVES; (void)gw; (void)NGW; \
    unsigned char* ws_ = a.ws; asm volatile("" : "+s"(ws_)); unsigned char* ws = (unsigned char*)(GAS unsigned char*)ws_; \
    float* mod = (float*)(ws + WS_MOD); float2* tab64 = (float2*)(ws + WS_TAB); float2* tab128 = tab64 + 64 * 16; (void)mod; (void)tab64; (void)tab128; \
    bf16* WTin = (bf16*)(ws + WS_WTIN); bf16* WTout = (bf16*)(ws + WS_WTOUT); bf16* HA = (bf16*)(ws + WS_HA); float* cbuf = (float*)(ws + WS_CBUF); (void)WTin; (void)WTout; (void)HA; (void)cbuf; \
    bf16* S0 = (bf16*)(ws + WS_SLOT); bf16* S1 = (bf16*)(ws + WS_SLOT + SLOT_BYTES); bf16* S2 = (bf16*)(ws + WS_SLOT + 2 * SLOT_BYTES); bf16* S3 = (bf16*)(ws + WS_SLOT + 3 * SLOT_BYTES); (void)S0; (void)S1; (void)S2; (void)S3; \
    LAS float* scr = (LAS float*)(lds + wave * 16384); (void)scr;
#define IN(k) (lo <= (k) && (k) < hi)
#define SEAM(k) do { if ((k) + 1 < hi) { if ((k) == 0) grid.sync(); else { unsigned char* wsb_ = a.ws; asm volatile("" : "+s"(wsb_)); XcdBarrier bar_; bar_.bar = (unsigned*)(wsb_ + WS_BAR); bar_.x = xb_xcc_id(); bar_.st = (volatile LAS unsigned*)(lds + LDS_BARST); xcd_barrier(bar_); } } } while (0)
    if (hi - lo > 1) {
        if (threadIdx.x < 2) ((volatile LAS unsigned*)(lds + LDS_BARST))[threadIdx.x] = 0u;
        __syncthreads();
        unsigned char* wsb_ = a.ws; (void)xcd_barrier_post((unsigned*)(wsb_ + WS_BAR), (volatile LAS unsigned*)(lds + LDS_BARST));
    }

    if (IN(0)) { PHASE_LOCALS
        transpose_all<MAP_CONV>(argp(7), DM, 4 * DI, WTin, scr, gw, NGW, lane);
        transpose_all<MAP_ID>(argp(10), DI, DM, WTout, scr, gw, NGW, lane);
#ifdef PROBE_DUP_TRANS
        transpose_all<MAP_CONV>(argp(7), DM, 4 * DI, WTin, scr, gw, NGW, lane);
        transpose_all<MAP_ID>(argp(10), DI, DM, WTout, scr, gw, NGW, lane);
#endif
        for (int it = gw; it < 6144; it += NGW) mod_item(mod, scr, it, lane);
        if (bx == 0) {
            for (int i = tid; i < 64 * 16; i += NWAVES * 64) { const int pos = i >> 4, f = i & 15; const float ang = (float)pos * exp2f(-(float)f * (13.287712379549449f / 16.0f)); tab64[i] = make_float2(cosf(ang), sinf(ang)); }
            for (int i = tid; i < 64 * 32; i += NWAVES * 64) { const int pos = i >> 5, f = i & 31; const float ang = (float)pos * exp2f(-(float)f * (13.287712379549449f / 32.0f)); tab128[i] = make_float2(cosf(ang), sinf(ang)); }
        }
        SEAM(0);
    }
#pragma unroll
    for (int l = 0; l < 4; ++l) {
        const int base = 1 + 5 * l, kind = (l == 3) ? 0 : l;
        const int LB = l == 0 ? 4 : l == 1 ? 11 : l == 2 ? 23 : 31, LW = l == 0 ? 10 : l == 1 ? 22 : l == 2 ? 30 : 37;
#define XCUR (l == 0 ? argp(0) : (const float*)(const GAS float*)a.out)
#define CCUR (l == 0 ? argp(2) : (const float*)cbuf)
        const int m1 = (l == 3) ? ML : MT;
        if (IN(base)) { PHASE_LOCALS
            if (l > 0) {
                if (kind == 0) transpose_all<MAP_CONV>(argp(LB + 3), DM, 4 * DI, WTin, scr, gw, NGW, lane);
                else if (kind == 1) transpose_all<MAP_DIFF>(argp(LB + 3), DM, 4 * DI, WTin, scr, gw, NGW, lane);
                else transpose_all<MAP_WIN>(argp(LB + 3), DM, 2 * DI + 2048, WTin, scr, gw, NGW, lane);
                transpose_all<MAP_ID>(argp(LW), DI, DM, WTout, scr, gw, NGW, lane);
            }
#ifdef PROBE_DUP_TRANS
            if (l > 0) {
                if (kind == 0) transpose_all<MAP_CONV>(argp(LB + 3), DM, 4 * DI, WTin, scr, gw, NGW, lane);
                else if (kind == 1) transpose_all<MAP_DIFF>(argp(LB + 3), DM, 4 * DI, WTin, scr, gw, NGW, lane);
                else transpose_all<MAP_WIN>(argp(LB + 3), DM, 2 * DI + 2048, WTin, scr, gw, NGW, lane);
                transpose_all<MAP_ID>(argp(LW), DI, DM, WTout, scr, gw, NGW, lane);
            }
#endif
            const float* xc = XCUR; const float* cc = CCUR; const float* ng = argp(LB);
            float* slab = (float*)(ws + WS_SLAB); (void)slab;
            for (int row = gw; row < m1; row += NGW) { const bool lat = row < ML;
                if (lat || l == 0) norm_row(lat ? xc + (size_t)row * DM : cc + (size_t)(row - ML) * DM, ng, mod + (size_t)(l * 5 + (lat ? (row >> 12) : 4)) * 6144, HA + (size_t)row * DM, lane);
                else { const float* prev = l == 1 ? argp(2) : (const float*)cbuf;
                    norm_row(prev + (size_t)(row - ML) * DM, ng, mod + (size_t)(l * 5 + 4) * 6144, HA + (size_t)row * DM, lane, slab + (size_t)(row - ML) * DM, mod + (size_t)((l - 1) * 5 + 4) * 6144 + 4096, cbuf + (size_t)(row - ML) * DM); } }
#ifdef PROBE_DUP_NORMCONV
            {
            const float* xc = XCUR; const float* cc = CCUR; const float* ng = argp(LB);
            float* slab = (float*)(ws + WS_SLAB); (void)slab;
            for (int row = gw; row < m1; row += NGW) { const bool lat = row < ML;
                if (lat || l == 0) norm_row(lat ? xc + (size_t)row * DM : cc + (size_t)(row - ML) * DM, ng, mod + (size_t)(l * 5 + (lat ? (row >> 12) : 4)) * 6144, HA + (size_t)row * DM, lane);
                else { const float* prev = l == 1 ? argp(2) : (const float*)cbuf;
                    norm_row(prev + (size_t)(row - ML) * DM, ng, mod + (size_t)(l * 5 + 4) * 6144, HA + (size_t)row * DM, lane, slab + (size_t)(row - ML) * DM, mod + (size_t)((l - 1) * 5 + 4) * 6144 + 4096, cbuf + (size_t)(row - ML) * DM); } }
            }
#endif
            SEAM(base);
        }
        if (IN(base + 1)) { PHASE_LOCALS
            if (kind == 0) { pg8::Gemm g{HA, WTin, m1, 4 * DI, DM}; pg8::StaticOrder S; S.init(m1, 4 * DI, G, bx); pg8::EpiConv E{S0, S1};

#ifndef NO_G1C
                pg8::gemm_phase<pg8::EpiConv, pg8::StaticOrder, true, true>(lds, g, S, E);
#ifdef PROBE_DUP_G1
                pg8::gemm_phase<pg8::EpiConv, pg8::StaticOrder, true, true>(lds, g, S, E);
#endif
#endif
 }
            else if (kind == 1) { pg8::Gemm g{HA, WTin, m1, 4 * DI, DM}; pg8::StaticOrder S; S.init(m1, 4 * DI, G, bx); typedef pg8::EpiDiff<(long)(SLOT_BYTES / 2)> EpiS1; EpiS1 E{S0, argp(LB + 4), argp(LB + 5), (const float*)tab64, 0.125f * LOG2E};

#if !defined(NO_G1S) && !defined(NO_G1S1)
                pg8::gemm_phase<EpiS1, pg8::StaticOrder, true, true>(lds, g, S, E);
#ifdef PROBE_DUP_G1
                pg8::gemm_phase<EpiS1, pg8::StaticOrder, true, true>(lds, g, S, E);
#endif
#endif
 }
            else { pg8::Gemm g{HA, WTin, m1, 2 * DI + 2048, DM}; pg8::StaticOrder S; S.init(m1, 2 * DI + 2048, G, bx); typedef pg8::EpiWin<(long)(SLOT_BYTES / 2), (long)MT> EpiS2; EpiS2 E{S0, argp(LB + 4), argp(LB + 5), (const float*)tab128, 0.08838834764831845f * LOG2E, (LAS float*)(lds + 131072)};

#if !defined(NO_G1S) && !defined(NO_G1S2)
                pg8::gemm_phase<EpiS2, pg8::StaticOrder, true, true>(lds, g, S, E);
#ifdef PROBE_DUP_G1
                pg8::gemm_phase<EpiS2, pg8::StaticOrder, true, true>(lds, g, S, E);
#endif
#endif
 }
            SEAM(base + 1);
        }
        if (kind == 0 && IN(base + 2)) { PHASE_LOCALS
            if (kind == 0) { for (int it = bx; it < m1 / 16; it += G) conv_item(S0, S1, S2, argp(LB + 4), argp(LB + 5), it, tid); }
#ifdef PROBE_DUP_NORMCONV
            if (kind == 0) { for (int it = bx; it < m1 / 16; it += G) conv_item(S0, S1, S2, argp(LB + 4), argp(LB + 5), it, tid); }
#endif
            else if (kind == 1) {
                qknorm_all<64>(S0, DI, MT * 8, argp(LB + 4), 0.125f * LOG2E, tab64, gw, NGW, lane);
                qknorm_all<64>(S1, DI, MT * 8, argp(LB + 5), 1.0f, tab64, gw, NGW, lane);
            } else {
                qknorm_all<128>(S0, DI, ML * 8, argp(LB + 4), 0.08838834764831845f * LOG2E, tab128, gw, NGW, lane);
                qknorm_all<128>(S1, 1024, MT * 2, argp(LB + 5), 1.0f, tab128, gw, NGW, lane);
            }
            SEAM(base + 2);
        }
        if (kind != 0 && IN(base + 3)) { PHASE_LOCALS
            if (kind == 1) {
                const float gq = wave_max(fabsf(argp(LB + 4)[lane])), gk = wave_max(fabsf(argp(LB + 5)[lane]));
                const float d1 = wave_sum(argp(LB + 6)[lane] * argp(LB + 7)[lane]), d2 = wave_sum(argp(LB + 8)[lane] * argp(LB + 9)[lane]);
                const float lam = expf(d1) - expf(d2) + LAM_INIT1;
#ifndef NO_ATTN1
#ifdef PROBE_DUP_ATTN
                attn_phase<true, PROBE_DUP_ATTN - 1>(lds, S0, (bf16*)(ws + WS_END), S1, S2, S3, DI, 8.0f * gq * gk * LOG2E, lam, argp(LB + 10), nullptr, 1.0f - LAM_INIT1, G, vcu);
#endif
                attn_phase<true>(lds, S0, S0, S1, S2, S3, DI, 8.0f * gq * gk * LOG2E, lam, argp(LB + 10), nullptr, 1.0f - LAM_INIT1, G, vcu);
#endif
            } else {
                const float gq = wave_max(fmaxf(fabsf(argp(LB + 4)[lane]), fabsf(argp(LB + 4)[lane + 64]))), gk = wave_max(fmaxf(fabsf(argp(LB + 5)[lane]), fabsf(argp(LB + 5)[lane + 64])));
#ifndef NO_ATTN2
#ifdef PROBE_DUP_WATTN
                attn_phase<false>(lds, S0, (bf16*)(ws + WS_END), S1, S1 + (size_t)MT * 1024, S3, 1024, 11.313708498984761f * gq * gk * LOG2E, 0.f, nullptr, argp(LB + 6), 1.0f, G, vcu);
#endif
                attn_phase<false>(lds, S0, S0, S1, S1 + (size_t)MT * 1024, S3, 1024, 11.313708498984761f * gq * gk * LOG2E, 0.f, nullptr, argp(LB + 6), 1.0f, G, vcu);
#endif
            }
            SEAM(base + 3);
        }
        if (IN(base + 4)) { PHASE_LOCALS
            { pg8::Gemm g{kind == 0 ? S2 : S0, WTout, ML, DM, DI}; pg8::StaticOrder S; S.init(ML, DM, G, bx);
              pg8::EpiResid E{XCUR, (float*)(GAS float*)a.out, mod + (size_t)l * 5 * 6144};
              pg8::gemm_phase<pg8::EpiResid, pg8::StaticOrder, G2_ALIGN, true>(lds, g, S, E);
#ifdef PROBE_DUP_G2L0
              if (l == 0) pg8::gemm_phase<pg8::EpiResid, pg8::StaticOrder, G2_ALIGN, true>(lds, g, S, E);
#endif
            }
            if (l < 2) {
                pg8::Gemm g{kind == 0 ? S2 : S0, WTout, MT, DM, 512, DI}; pg8::SplitOrder S{bx, G}; pg8::EpiSlab E{(float*)(ws + WS_SLAB)};
#ifndef NO_SPLIT
                pg8::gemm_phase<pg8::EpiSlab, pg8::SplitOrder, true, true>(lds, g, S, E);
#endif
            }
            SEAM(base + 4);
        }
    }
#undef IN
#undef SEAM
}

extern "C" void kernel_launch(void* const* d_in, const int* in_sizes, int n_in, void* d_out, int out_size, void* d_ws, size_t ws_size, hipStream_t stream) {
    static int grid = 0;
    if (grid == 0) {
        if (n_in != 38 || in_sizes[0] != ML * DM || out_size != ML * DM || ws_size < WS_END) { fprintf(stderr, "kernel_launch: unexpected shapes (n_in %d, out %d, ws %zu < %zu)\n", n_in, out_size, ws_size, (size_t)WS_END); grid = -1; return; }
        int dev = 0, cus = 0, per_cu = 0;
        if (hipGetDevice(&dev) != hipSuccess || hipDeviceGetAttribute(&cus, hipDeviceAttributeMultiprocessorCount, dev) != hipSuccess) { grid = -1; return; }
        if (hipFuncSetAttribute((const void*)mk_fwd, hipFuncAttributeMaxDynamicSharedMemorySize, LDS_BYTES) != hipSuccess) { fprintf(stderr, "kernel_launch: hipFuncSetAttribute failed\n"); grid = -1; return; }
        if (hipOccupancyMaxActiveBlocksPerMultiprocessor(&per_cu, (const void*)mk_fwd, NWAVES * 64, LDS_BYTES) != hipSuccess || per_cu < 1) { fprintf(stderr, "kernel_launch: occupancy query says %d\n", per_cu); per_cu = 1; }
        (void)hipGetLastError();
        grid = cus;
    }
    if (grid < 0) return;
    (void)hipMemsetAsync((char*)d_ws + WS_MOD, 0, MOD_ZERO_BYTES, stream);
    Args a{};
    for (int i = 0; i < 38; ++i) a.in[i] = (const float*)d_in[i];
    a.out = (float*)d_out; a.ws = (unsigned char*)d_ws;
#if MK_SINGLE
    a.ph_lo = 0; a.ph_hi = NPH;
    void* params[] = {&a};
    const hipError_t e = hipLaunchCooperativeKernel((const void*)mk_fwd, dim3(grid), dim3(NWAVES * 64), params, LDS_BYTES, stream);
    if (e != hipSuccess) fprintf(stderr, "kernel_launch: cooperative launch failed: %s (grid %d)\n", hipGetErrorString(e), grid);
#else
    for (int ph = 0; ph < NPH; ++ph) {
        if (ph == 4 || ph == 19) continue;
        a.ph_lo = ph; a.ph_hi = ph + 1;
        hipLaunchKernelGGL(mk_fwd, dim3(grid), dim3(NWAVES * 64), LDS_BYTES, stream, a);
    }
#endif
}
```

```cpp
#include <hip/hip_runtime.h>
#include <hip/hip_cooperative_groups.h>
#include <cstdio>
#include <cstdint>
#define MK_SINGLE 1
namespace pg8 {
#define PG8_LAS __attribute__((address_space(3)))
typedef unsigned short bf16_t;
typedef short bf16x8 __attribute__((ext_vector_type(8)));
typedef float f32x4 __attribute__((ext_vector_type(4)));
typedef unsigned u32x4 __attribute__((ext_vector_type(4)));
constexpr int BM = 256, BK = 64, HALF = 128, HTB = HALF * BK * 2  , STAGE_BYTES = 8 * HTB, NXCD = 8, WGM = 8;

__host__ __device__ __forceinline__ int lds_byte(int r, int c) { const int st = (r >> 4) * 2 + (c >> 5), rr = r & 15, cc = c & 31, ob = rr * 64 + cc * 2; return st * 1024 + (ob ^ (((ob >> 9) & 1) << 5)); }
__host__ __device__ __forceinline__ void stage_rc(int b, int& R, int& C) { const int st = b / 1024, sb = b % 1024, swz = sb ^ (((sb >> 9) & 1) << 5); R = (st >> 1) * 16 + swz / 64; C = (st & 1) * 32 + (swz % 64) / 2; }
__host__ __device__ __forceinline__ int perm32(int rho) { const int n = rho >> 4, i = rho & 15; return 8 * (i >> 2) + 4 * n + (i & 3); }

struct Unit { int pm, pn, ko; };
struct Gemm { const bf16_t* A; const bf16_t* Bt; int M, N, K; int ld = 0; };

struct StaticOrder {
    int nM, nN, nwg, G, c;
    __host__ __device__ void init(int M, int N, int G_, int c_) { nM = M / BM; nN = N / BM; nwg = nM * nN; G = G_; c = c_; }
    __host__ __device__ bool next(int i, Unit& u) const {
        const long L = (long)i * G + c; if (L >= nwg) return false;
        int wgid = (int)L; { const int q = nwg / NXCD, r = nwg % NXCD, xcd = wgid % NXCD, off = wgid / NXCD; wgid = (xcd < r ? xcd * (q + 1) : r * (q + 1) + (xcd - r) * q) + off; }
        const int nig = WGM * nN, gid = wgid / nig, fm = gid * WGM, gsz = (nM - fm) < WGM ? (nM - fm) : WGM;
        u.pm = fm + ((wgid % nig) % gsz); u.pn = (wgid % nig) / gsz; u.ko = 0; return true;
    }
    __device__ __forceinline__ void a_ready(const Unit&) const {}
    __device__ __forceinline__ void done(const Unit&) const {}
};
struct SplitOrder {
    int c, G;
    __host__ __device__ bool next(int i, Unit& u) const { const int L = i * G + c; if (L >= 256) return false; u.pm = 64 + (L >> 6); u.pn = (L >> 3) & 7; u.ko = (L & 7) * 512; return true; }
    __device__ __forceinline__ void a_ready(const Unit&) const {}
    __device__ __forceinline__ void done(const Unit&) const {}
};
__device__ __forceinline__ unsigned cvt_pk_bf16(float lo, float hi) { unsigned r; asm volatile("v_cvt_pk_bf16_f32 %0, %1, %2" : "=v"(r) : "v"(lo), "v"(hi)); return r; }
typedef float f32x2 __attribute__((ext_vector_type(2)));
typedef unsigned u32x2 __attribute__((ext_vector_type(2)));
#define PG8_GAS __attribute__((address_space(1)))
__device__ __forceinline__ float silu_f(float z) { return z * __builtin_amdgcn_rcpf(1.0f + __builtin_amdgcn_exp2f(-1.4426950408889634f * z)); }

template <int KIND, long SLOT, long MROWS> struct EpiSplit {
    static constexpr bool PERM = false, AFTER_DRAIN = false;
    bf16_t* base;
    __device__ __forceinline__ void operator()(const f32x4 (&acc)[2][2][4][2], const Unit& u, int wr, int wc, int fr, int fq) const {
        const int pn = u.pn; long boff; int ld, tt;
        if (KIND == 1) { const int s = pn >> 4; boff = (long)s * SLOT; ld = 4096; tt = s << 4; }
        else { if (pn < 16) { boff = 0; ld = 4096; tt = 0; } else if (pn < 20) { boff = SLOT; ld = 1024; tt = 16; } else if (pn < 24) { boff = SLOT + MROWS * 1024; ld = 1024; tt = 20; } else { boff = 3 * SLOT; ld = 4096; tt = 24; } }
        const int row0 = u.pm * BM + wr * 64 + fr, col0 = (pn - tt) * BM + wc * 32 + 8 * fq;
        bf16_t* B = base + boff + (size_t)row0 * ld + col0;
#pragma unroll
        for (int ai = 0; ai < 2; ++ai)
#pragma unroll
            for (int m = 0; m < 4; ++m) { bf16_t* rowp = B + (size_t)((ai * HALF + m * 16) * ld);
#pragma unroll
                for (int bj = 0; bj < 2; ++bj) { const f32x4 v0 = acc[ai][bj][m][0], v1 = acc[ai][bj][m][1];
                    u32x4 w; w.x = cvt_pk_bf16(v0[0], v0[1]); w.y = cvt_pk_bf16(v0[2], v0[3]); w.z = cvt_pk_bf16(v1[0], v1[1]); w.w = cvt_pk_bf16(v1[2], v1[3]);
                    *(PG8_GAS u32x4*)(rowp + bj * HALF) = w; } }
    }
};
template <long SLOT> struct EpiDiff {
    static constexpr bool PERM = false, AFTER_DRAIN = false;
    bf16_t* base; const float* qn; const float* kn; const float* tab; float qscale;
    __device__ __forceinline__ void operator()(const f32x4 (&acc)[2][2][4][2], const Unit& u, int wr, int wc, int fr, int fq) const {
        const int pn = u.pn;
        if (pn >= 32) {
            const int s = pn >> 4; const int row0 = u.pm * BM + wr * 64 + fr, col0 = (pn - (s << 4)) * BM + wc * 32 + 8 * fq;
            bf16_t* B = base + (long)s * SLOT + (size_t)row0 * 4096 + col0;
#pragma unroll
            for (int ai = 0; ai < 2; ++ai)
#pragma unroll
                for (int m = 0; m < 4; ++m) { bf16_t* rowp = B + (size_t)((ai * HALF + m * 16) * 4096);
#pragma unroll
                    for (int bj = 0; bj < 2; ++bj) { const f32x4 v0 = acc[ai][bj][m][0], v1 = acc[ai][bj][m][1];
                        u32x4 w; w.x = cvt_pk_bf16(v0[0], v0[1]); w.y = cvt_pk_bf16(v0[2], v0[3]); w.z = cvt_pk_bf16(v1[0], v1[1]); w.w = cvt_pk_bf16(v1[2], v1[3]);
                        *(PG8_GAS u32x4*)(rowp + bj * HALF) = w; } }
            return;
        }
        const bool isq = pn < 16, latent = u.pm < 64;
        const float* gain = isq ? qn : kn; const float osc = isq ? qscale : 1.0f;
        f32x4 gg[2][2];
#pragma unroll
        for (int bj = 0; bj < 2; ++bj)
#pragma unroll
            for (int n = 0; n < 2; ++n) gg[bj][n] = *(const PG8_GAS f32x4*)(gain + 32 * bj + 16 * n + 4 * fq);
        bf16_t* B = base + (isq ? 0 : SLOT) + (size_t)(u.pm * BM + wr * 64 + fr) * 4096 + (pn & 15) * BM + 64 * wc + 16 * fq;
#pragma unroll
        for (int ai = 0; ai < 2; ++ai) {
            const int prow = (4 * u.pm + 2 * ai + wr) & 63;
            const f32x4 ra = *(const PG8_GAS f32x4*)(tab + (prow * 16 + 4 * fq) * 2), rb = *(const PG8_GAS f32x4*)(tab + (prow * 16 + 4 * fq) * 2 + 4);
#pragma unroll
            for (int m = 0; m < 4; ++m) {
                const int pcol = 16 * m + fr;
                const f32x4 ca = *(const PG8_GAS f32x4*)(tab + (pcol * 16 + 4 * fq) * 2), cb = *(const PG8_GAS f32x4*)(tab + (pcol * 16 + 4 * fq) * 2 + 4);
                f32x4 y[2][2]; float ss = 0.f;
#pragma unroll
                for (int bj = 0; bj < 2; ++bj)
#pragma unroll
                    for (int n = 0; n < 2; ++n) { y[bj][n] = acc[ai][bj][m][n]; ss += (y[bj][n][0] * y[bj][n][0] + y[bj][n][1] * y[bj][n][1]) + (y[bj][n][2] * y[bj][n][2] + y[bj][n][3] * y[bj][n][3]); }
                ss += __shfl_xor(ss, 16); ss += __shfl_xor(ss, 32);
                const float rstd = 1.0f / sqrtf(ss * (1.0f / 64.0f) + 1e-6f);
#pragma unroll
                for (int bj = 0; bj < 2; ++bj)
#pragma unroll
                    for (int n = 0; n < 2; ++n) y[bj][n] = y[bj][n] * rstd * gg[bj][n];
                if (latent) {
#pragma unroll
                    for (int bj = 0; bj < 2; ++bj) { const f32x4 A = bj == 0 ? ra : ca, Bv = bj == 0 ? rb : cb;
                        const f32x4 c = {A[0], A[2], Bv[0], Bv[2]}, sn = {A[1], A[3], Bv[1], Bv[3]};
                        const f32x4 t1 = y[bj][0], t2 = y[bj][1]; y[bj][0] = t1 * c - t2 * sn; y[bj][1] = t1 * sn + t2 * c; }
                }
                bf16_t* rowp = B + (size_t)((ai * HALF + m * 16) * 4096);
#pragma unroll
                for (int bj = 0; bj < 2; ++bj) { const f32x4 v0 = y[bj][0] * osc, v1 = y[bj][1] * osc;
                    u32x4 w; w.x = cvt_pk_bf16(v0[0], v0[1]); w.y = cvt_pk_bf16(v0[2], v0[3]); w.z = cvt_pk_bf16(v1[0], v1[1]); w.w = cvt_pk_bf16(v1[2], v1[3]);
                    *(PG8_GAS u32x4*)(rowp + 8 * bj) = w; }
            }
        }
    }
};
template <long SLOT, long MROWS> struct EpiWin {
    static constexpr bool PERM = false, AFTER_DRAIN = false;
    bf16_t* base; const float* qn; const float* kn; const float* tab; float qscale; PG8_LAS float* xch;
    __device__ __forceinline__ void operator()(const f32x4 (&acc)[2][2][4][2], const Unit& u, int wr, int wc, int fr, int fq) const {
        const int pn = u.pn;
        if (pn >= 20) {
            long boff; int ld, tt; if (pn < 24) { boff = SLOT + MROWS * 1024; ld = 1024; tt = 20; } else { boff = 3 * SLOT; ld = 4096; tt = 24; }
            const int row0 = u.pm * BM + wr * 64 + fr, col0 = (pn - tt) * BM + wc * 32 + 8 * fq;
            bf16_t* B = base + boff + (size_t)row0 * ld + col0;
#pragma unroll
            for (int ai = 0; ai < 2; ++ai)
#pragma unroll
                for (int m = 0; m < 4; ++m) { bf16_t* rowp = B + (size_t)((ai * HALF + m * 16) * ld);
#pragma unroll
                    for (int bj = 0; bj < 2; ++bj) { const f32x4 v0 = acc[ai][bj][m][0], v1 = acc[ai][bj][m][1];
                        u32x4 w; w.x = cvt_pk_bf16(v0[0], v0[1]); w.y = cvt_pk_bf16(v0[2], v0[3]); w.z = cvt_pk_bf16(v1[0], v1[1]); w.w = cvt_pk_bf16(v1[2], v1[3]);
                        *(PG8_GAS u32x4*)(rowp + bj * HALF) = w; } }
            return;
        }
        const bool isq = pn < 16, latent = u.pm < 64; const int w1 = wc & 1;
        const float* gain = isq ? qn : kn; const float osc = isq ? qscale : 1.0f;
        f32x4 gg[2][2];
#pragma unroll
        for (int bj = 0; bj < 2; ++bj)
#pragma unroll
            for (int n = 0; n < 2; ++n) gg[bj][n] = *(const PG8_GAS f32x4*)(gain + 64 * w1 + 32 * bj + 16 * n + 4 * fq);
        float ps[2][4];
#pragma unroll
        for (int ai = 0; ai < 2; ++ai)
#pragma unroll
            for (int m = 0; m < 4; ++m) { float ss = 0.f;
#pragma unroll
                for (int bj = 0; bj < 2; ++bj)
#pragma unroll
                    for (int n = 0; n < 2; ++n) { const f32x4 v = acc[ai][bj][m][n]; ss += (v[0] * v[0] + v[1] * v[1]) + (v[2] * v[2] + v[3] * v[3]); }
                ss += __shfl_xor(ss, 16); ss += __shfl_xor(ss, 32); ps[ai][m] = ss;
                if (fq == 0) xch[(ai * HALF + wr * 64 + m * 16 + fr) * 4 + wc] = ss; }
        asm volatile("s_waitcnt lgkmcnt(0)" ::: "memory"); __builtin_amdgcn_s_barrier(); asm volatile("" ::: "memory");
#pragma unroll
        for (int ai = 0; ai < 2; ++ai)
#pragma unroll
            for (int m = 0; m < 4; ++m) ps[ai][m] += xch[(ai * HALF + wr * 64 + m * 16 + fr) * 4 + (wc ^ 1)];
        const int ldo = isq ? 4096 : 1024;
        bf16_t* B = base + (isq ? (long)pn * BM : SLOT + (long)(pn - 16) * BM) + (size_t)(u.pm * BM + wr * 64 + fr) * ldo + 64 * wc + 16 * fq;
#pragma unroll
        for (int ai = 0; ai < 2; ++ai) {
            const int prow = (4 * u.pm + 2 * ai + wr) & 63;
#pragma unroll
            for (int m = 0; m < 4; ++m) {
                const int pos = w1 ? (16 * m + fr) : prow;
                const float rstd = 1.0f / sqrtf(ps[ai][m] * (1.0f / 128.0f) + 1e-6f);
                f32x4 y[2][2];
#pragma unroll
                for (int bj = 0; bj < 2; ++bj)
#pragma unroll
                    for (int n = 0; n < 2; ++n) y[bj][n] = acc[ai][bj][m][n] * rstd * gg[bj][n];
                if (latent) {
#pragma unroll
                    for (int n = 0; n < 2; ++n) { const float* tp = tab + (pos * 32 + 16 * n + 4 * fq) * 2;
                        const f32x4 A = *(const PG8_GAS f32x4*)tp, Bv = *(const PG8_GAS f32x4*)(tp + 4);
                        const f32x4 c = {A[0], A[2], Bv[0], Bv[2]}, sn = {A[1], A[3], Bv[1], Bv[3]};
                        const f32x4 t1 = y[0][n], t2 = y[1][n]; y[0][n] = t1 * c - t2 * sn; y[1][n] = t1 * sn + t2 * c; }
                }
                bf16_t* rowp = B + (size_t)((ai * HALF + m * 16) * ldo);
#pragma unroll
                for (int bj = 0; bj < 2; ++bj) { const f32x4 v0 = y[bj][0] * osc, v1 = y[bj][1] * osc;
                    u32x4 w; w.x = cvt_pk_bf16(v0[0], v0[1]); w.y = cvt_pk_bf16(v0[2], v0[3]); w.z = cvt_pk_bf16(v1[0], v1[1]); w.w = cvt_pk_bf16(v1[2], v1[3]);
                    *(PG8_GAS u32x4*)(rowp + 8 * bj) = w; }
            }
        }
    }
};
struct EpiConv {
    static constexpr bool PERM = false, AFTER_DRAIN = false;
    bf16_t* U; bf16_t* BZ;
    __device__ __forceinline__ void operator()(const f32x4 (&acc)[2][2][4][2], const Unit& u, int wr, int wc, int fr, int fq) const {
        const int row0 = u.pm * BM + wr * 64 + fr, col0 = u.pn * 64 + wc * 16 + 4 * fq;
#pragma unroll
        for (int ai = 0; ai < 2; ++ai)
#pragma unroll
            for (int m = 0; m < 4; ++m) { const size_t off = (size_t)(row0 + ai * HALF + m * 16) * 4096 + col0;
                const f32x4 bg = acc[ai][0][m][0], cg = acc[ai][0][m][1], xt = acc[ai][1][m][0], z = acc[ai][1][m][1];
                const f32x4 uu = cg * xt; f32x4 bz; bz[0] = bg[0] * silu_f(z[0]); bz[1] = bg[1] * silu_f(z[1]); bz[2] = bg[2] * silu_f(z[2]); bz[3] = bg[3] * silu_f(z[3]);
                u32x2 a; a.x = cvt_pk_bf16(uu[0], uu[1]); a.y = cvt_pk_bf16(uu[2], uu[3]); *(PG8_GAS u32x2*)(U + off) = a;
                u32x2 b; b.x = cvt_pk_bf16(bz[0], bz[1]); b.y = cvt_pk_bf16(bz[2], bz[3]); *(PG8_GAS u32x2*)(BZ + off) = b; }
    }
};
struct EpiConvF {
    static constexpr bool PERM = false, AFTER_DRAIN = false;
    bf16_t* G; float* H; const float* cw; const float* cb; PG8_LAS float* xch; int ntiles;
    __device__ __forceinline__ void operator()(const f32x4 (&acc)[2][2][4][2], const Unit& u, int wr, int wc, int fr, int fq) const {
        const int col0 = u.pn * 64 + wc * 16 + 4 * fq, lane = fr + 16 * fq;
        const f32x4 w0 = *(const PG8_GAS f32x4*)(cw + col0), w1 = *(const PG8_GAS f32x4*)(cw + 4096 + col0), w2 = *(const PG8_GAS f32x4*)(cw + 8192 + col0), bb = *(const PG8_GAS f32x4*)(cb + col0);
        f32x4 uu[2][4], bzv[2][4];
#pragma unroll
        for (int ai = 0; ai < 2; ++ai)
#pragma unroll
            for (int m = 0; m < 4; ++m) { const f32x4 bg = acc[ai][0][m][0], cg = acc[ai][0][m][1], xt = acc[ai][1][m][0], z = acc[ai][1][m][1];
                uu[ai][m] = cg * xt; f32x4 b; b[0] = bg[0] * silu_f(z[0]); b[1] = bg[1] * silu_f(z[1]); b[2] = bg[2] * silu_f(z[2]); b[3] = bg[3] * silu_f(z[3]); bzv[ai][m] = b; }
        PG8_LAS float* xw = xch + wc * 16 + 4 * fq;
#pragma unroll
        for (int ai = 0; ai < 2; ++ai) { const int b = 2 * ai + wr;
            if (fr == 0) *(PG8_LAS f32x4*)(xw + (b * 2 + 0) * 64) = uu[ai][0];
            if (fr == 15) *(PG8_LAS f32x4*)(xw + (b * 2 + 1) * 64) = uu[ai][3]; }
        asm volatile("s_waitcnt lgkmcnt(0)" ::: "memory"); __builtin_amdgcn_s_barrier(); asm volatile("" ::: "memory");
        const int upl = (lane & 48) | ((fr + 15) & 15), dnl = (lane & 48) | ((fr + 1) & 15);
        const f32x4 zero4 = {0.f, 0.f, 0.f, 0.f};
#pragma unroll
        for (int ai = 0; ai < 2; ++ai) { const int b = 2 * ai + wr;
            const f32x4 prevX = b > 0 ? *(const PG8_LAS f32x4*)(xw + ((b - 1) * 2 + 1) * 64) : zero4;
            const f32x4 nextX = b < 3 ? *(const PG8_LAS f32x4*)(xw + ((b + 1) * 2 + 0) * 64) : zero4;
#pragma unroll
            for (int m = 0; m < 4; ++m) {
                const f32x4 su = (m > 0 && fr == 15) ? uu[ai][m > 0 ? m - 1 : 0] : uu[ai][m];
                const f32x4 sd = (m < 3 && fr == 0) ? uu[ai][m < 3 ? m + 1 : 3] : uu[ai][m];
                f32x4 up, dn;
#pragma unroll
                for (int e = 0; e < 4; ++e) { up[e] = __shfl(su[e], upl); dn[e] = __shfl(sd[e], dnl); }
                if (m == 0 && fr == 0) up = prevX;
                if (m == 3 && fr == 15) dn = nextX;
                const f32x4 mid = w1 * uu[ai][m] + bb, y = w0 * up + mid + w2 * dn, g = bzv[ai][m] * y;
                const size_t row = (size_t)u.pm * BM + ai * HALF + wr * 64 + m * 16 + fr;
                u32x2 o; o.x = cvt_pk_bf16(g[0], g[1]); o.y = cvt_pk_bf16(g[2], g[3]); *(PG8_GAS u32x2*)(G + row * 4096 + col0) = o;
                if (b == 0 && m == 0 && fr == 0) { float* h = H + ((size_t)u.pm * 2 + 0) * 4096 + col0; const size_t hs = (size_t)ntiles * 2 * 4096;
                    *(PG8_GAS f32x4*)h = uu[ai][m]; *(PG8_GAS f32x4*)(h + hs) = mid + w2 * dn; *(PG8_GAS f32x4*)(h + 2 * hs) = bzv[ai][m]; }
                if (b == 3 && m == 3 && fr == 15) { float* h = H + ((size_t)u.pm * 2 + 1) * 4096 + col0; const size_t hs = (size_t)ntiles * 2 * 4096;
                    *(PG8_GAS f32x4*)h = uu[ai][m]; *(PG8_GAS f32x4*)(h + hs) = w0 * up + mid; *(PG8_GAS f32x4*)(h + 2 * hs) = bzv[ai][m]; }
            }
        }
    }
};
struct EpiResid {
    static constexpr bool PERM = false, AFTER_DRAIN = false;
    const float* xin; float* xout; const float* mod;
    __device__ __forceinline__ void operator()(const f32x4 (&acc)[2][2][4][2], const Unit& u, int wr, int wc, int fr, int fq) const {
        const float* src = xin + (size_t)u.pm * BM * 2048; float* dst = xout + (size_t)u.pm * BM * 2048;
        const float* gate = mod + (u.pm >> 4) * 6144 + 4096;
        const int rl = wr * 64 + fr, col0 = u.pn * BM + wc * 32 + 4 * fq;
        f32x4 gv[2][2];
#pragma unroll
        for (int bj = 0; bj < 2; ++bj)
#pragma unroll
            for (int n = 0; n < 2; ++n) gv[bj][n] = *(const PG8_GAS f32x4*)(gate + col0 + bj * HALF + n * 16);
#pragma unroll
        for (int ai = 0; ai < 2; ++ai)
#pragma unroll
            for (int mp = 0; mp < 2; ++mp) { f32x4 xs[2][2][2];
#pragma unroll
                for (int mm = 0; mm < 2; ++mm) { const size_t off = (size_t)(rl + ai * HALF + (2 * mp + mm) * 16) * 2048 + col0;
#pragma unroll
                    for (int bj = 0; bj < 2; ++bj)
#pragma unroll
                        for (int n = 0; n < 2; ++n) xs[mm][bj][n] = *(const PG8_GAS f32x4*)(src + off + bj * HALF + n * 16); }
#pragma unroll
                for (int mm = 0; mm < 2; ++mm) { const size_t off = (size_t)(rl + ai * HALF + (2 * mp + mm) * 16) * 2048 + col0;
#pragma unroll
                    for (int bj = 0; bj < 2; ++bj)
#pragma unroll
                        for (int n = 0; n < 2; ++n) *(PG8_GAS f32x4*)(dst + off + bj * HALF + n * 16) = xs[mm][bj][n] + gv[bj][n] * acc[ai][bj][2 * mp + mm][n]; }
                asm volatile("" ::: "memory"); }
    }
};
struct EpiSlab {
    static constexpr bool PERM = false, AFTER_DRAIN = false;
    float* slab;
    __device__ __forceinline__ void operator()(const f32x4 (&acc)[2][2][4][2], const Unit& u, int wr, int wc, int fr, int fq) const {
        float* dst = slab + ((size_t)(u.ko >> 9) * 1024 + (size_t)(u.pm - 64) * BM) * 2048;
        const int rl = wr * 64 + fr, col0 = u.pn * BM + wc * 32 + 4 * fq;
#pragma unroll
        for (int ai = 0; ai < 2; ++ai)
#pragma unroll
            for (int m = 0; m < 4; ++m) { const size_t off = (size_t)(rl + ai * HALF + m * 16) * 2048 + col0;
#pragma unroll
                for (int bj = 0; bj < 2; ++bj)
#pragma unroll
                    for (int n = 0; n < 2; ++n) *(PG8_GAS f32x4*)(dst + off + bj * HALF + n * 16) = acc[ai][bj][m][n]; }
    }
};
template <class Epi, class Sched, bool ALIGN_EPI = false, bool SP2 = false>
__device__ __forceinline__ void gemm_phase(PG8_LAS unsigned char* lds, const Gemm g, const Sched& S, const Epi& E) {
    int tid_ = threadIdx.x; asm volatile("" : "+v"(tid_));
    const int tid = tid_, wid = __builtin_amdgcn_readfirstlane(tid >> 6), lane = tid & 63, wr = wid >> 2, wc = wid & 3, fr = lane & 15, fq = lane >> 4;
    const int K = g.K, nt = K / BK, LD = g.ld ? g.ld : g.K;
    unsigned voffA[2], voffB[2];
#pragma unroll
    for (int i = 0; i < 2; ++i) { int R, C; stage_rc(tid * 16 + i * 8192, R, C); const int Rb = Epi::PERM ? ((R & ~31) + perm32(R & 31)) : R;
        voffA[i] = (unsigned)(R * LD + C) * 2u; voffB[i] = (unsigned)(Rb * LD + C) * 2u; }
    const size_t kstep = (size_t)(BK * 2);
    const size_t hstep = (size_t)HALF * LD * 2;
    const size_t tstep = 2 * hstep;
    const unsigned ldsw = (unsigned)wid * 1024u;
    const int aoff = lds_byte(wr * 64 + fr, fq * 8), boff = lds_byte(wc * 32 + fr, fq * 8);
#define PG8_SA(b, h) (((b) * 2 + (h)) * HTB)
#define PG8_SB(b, h) ((4 + (b) * 2 + (h)) * HTB)
#define PG8_STAGE(bufoff, gbase, voff) do { _Pragma("unroll") for (int _i = 0; _i < 2; ++_i) \
        __builtin_amdgcn_global_load_lds((const unsigned*)((const char*)(gbase) + (voff)[_i]), (PG8_LAS unsigned*)(lds + (bufoff) + ldsw + _i * 8192), 16, 0, 0); } while (0)
#define PG8_LDA(dst, b, h) do { _Pragma("unroll") for (int m = 0; m < 4; ++m) _Pragma("unroll") for (int k = 0; k < 2; ++k) dst[m][k] = *(const PG8_LAS bf16x8*)(lds + PG8_SA(b, h) + aoff + m * 2048 + k * 1024); } while (0)
#define PG8_LDB(dst, b, h) do { _Pragma("unroll") for (int n = 0; n < 2; ++n) _Pragma("unroll") for (int k = 0; k < 2; ++k) dst[n][k] = *(const PG8_LAS bf16x8*)(lds + PG8_SB(b, h) + boff + n * 2048 + k * 1024); } while (0)
#define PG8_MMA(ai, bj, At, Bt) do { __builtin_amdgcn_s_setprio(1); _Pragma("unroll") for (int m = 0; m < 4; ++m) _Pragma("unroll") for (int n = 0; n < 2; ++n) _Pragma("unroll") for (int k = 0; k < 2; ++k) \
        acc[ai][bj][m][n] = __builtin_amdgcn_mfma_f32_16x16x32_bf16(Bt[n][k], At[m][k], acc[ai][bj][m][n], 0, 0, 0); __builtin_amdgcn_s_setprio(0); } while (0)
#define PG8_WAIT_V(n) asm volatile("s_waitcnt vmcnt(" #n ")" ::: "memory")
#define PG8_WAIT_L(n) asm volatile("s_waitcnt lgkmcnt(" #n ")" ::: "memory")
#define PG8_BAR __builtin_amdgcn_s_barrier()
#define PG8_SCHED __builtin_amdgcn_sched_barrier(0)
    Unit cur, nxt; int ui = 0;
    if (!S.next(0, cur)) return;
    f32x4 acc[2][2][4][2];
#pragma unroll
    for (int a = 0; a < 2; ++a)
#pragma unroll
        for (int b = 0; b < 2; ++b)
#pragma unroll
            for (int m = 0; m < 4; ++m)
#pragma unroll
                for (int n = 0; n < 2; ++n) acc[a][b][m][n] = (f32x4){0.f, 0.f, 0.f, 0.f};
    bf16x8 At[4][2], B0[2][2], B1[2][2];
    const char* cA = (const char*)g.A + (size_t)cur.pm * tstep + (size_t)cur.ko * 2; const char* cB = (const char*)g.Bt + (size_t)cur.pn * tstep + (size_t)cur.ko * 2;
    S.a_ready(cur);
    if constexpr (SP2) {
        PG8_STAGE(PG8_SB(0, 0), cB, voffB); PG8_STAGE(PG8_SB(0, 1), cB + hstep, voffB); PG8_STAGE(PG8_SA(0, 0), cA, voffA); PG8_STAGE(PG8_SA(0, 1), cA + hstep, voffA);
        if (wr == 1) PG8_BAR;
        PG8_WAIT_V(2); PG8_BAR;
        PG8_STAGE(PG8_SB(1, 0), cB + kstep, voffB); PG8_STAGE(PG8_SA(1, 0), cA + kstep, voffA); PG8_STAGE(PG8_SB(1, 1), cB + hstep + kstep, voffB);
        PG8_WAIT_V(6); PG8_BAR;
    } else {
        PG8_STAGE(PG8_SB(0, 0), cB, voffB); PG8_STAGE(PG8_SA(0, 0), cA, voffA); PG8_STAGE(PG8_SB(0, 1), cB + hstep, voffB); PG8_STAGE(PG8_SA(0, 1), cA + hstep, voffA);
        if (wr == 1) PG8_BAR;
        PG8_WAIT_V(4); PG8_BAR;
        PG8_STAGE(PG8_SB(1, 0), cB + kstep, voffB); PG8_STAGE(PG8_SA(1, 0), cA + kstep, voffA); PG8_STAGE(PG8_SB(1, 1), cB + hstep + kstep, voffB);
        PG8_WAIT_V(6); PG8_BAR;
    }
    for (;;) {
        const bool has_next = S.next(ui + 1, nxt);
        const char* nA = has_next ? (const char*)g.A + (size_t)nxt.pm * tstep + (size_t)nxt.ko * 2 : cA; const char* nB = has_next ? (const char*)g.Bt + (size_t)nxt.pn * tstep + (size_t)nxt.ko * 2 : cB;
        for (int t = 0; t < nt; t += 2) {
            const bool last = (t == nt - 2);
            const char* a1 = cA + (size_t)(t + 1) * kstep;
            const char* a2 = last ? nA : cA + (size_t)(t + 2) * kstep; const char* b2 = last ? nB : cB + (size_t)(t + 2) * kstep;
            const char* a3 = a2 + kstep; const char* b3 = b2 + kstep;
            if (last && has_next) S.a_ready(nxt);
            if constexpr (SP2) {
            PG8_LDB(B0, 0, 0); PG8_LDB(B1, 0, 1); PG8_SCHED; PG8_LDA(At, 0, 0); PG8_STAGE(PG8_SA(1, 1), a1 + hstep, voffA);
            PG8_WAIT_V(8); PG8_WAIT_L(0); PG8_BAR; PG8_MMA(0, 0, At, B0); PG8_MMA(0, 1, At, B1); PG8_BAR; PG8_SCHED;
            PG8_LDA(At, 0, 1); PG8_STAGE(PG8_SB(0, 0), b2, voffB); PG8_STAGE(PG8_SB(0, 1), b2 + hstep, voffB); PG8_STAGE(PG8_SA(0, 0), a2, voffA);
            PG8_WAIT_V(8); PG8_WAIT_L(0); PG8_BAR; PG8_MMA(1, 0, At, B0); PG8_MMA(1, 1, At, B1); PG8_BAR; PG8_SCHED;
            PG8_LDB(B0, 1, 0); PG8_LDB(B1, 1, 1); PG8_SCHED; PG8_LDA(At, 1, 0); PG8_STAGE(PG8_SA(0, 1), a2 + hstep, voffA);
            PG8_WAIT_V(8); PG8_WAIT_L(0); PG8_BAR; PG8_MMA(0, 0, At, B0); PG8_MMA(0, 1, At, B1); PG8_BAR; PG8_SCHED;
            PG8_LDA(At, 1, 1); PG8_STAGE(PG8_SB(1, 0), b3, voffB); PG8_STAGE(PG8_SB(1, 1), b3 + hstep, voffB); PG8_STAGE(PG8_SA(1, 0), a3, voffA);
            PG8_WAIT_V(8); PG8_WAIT_L(0); PG8_BAR; PG8_MMA(1, 0, At, B0); PG8_MMA(1, 1, At, B1); PG8_BAR; PG8_SCHED;
            } else {
            PG8_LDB(B0, 0, 0); PG8_SCHED; PG8_LDA(At, 0, 0); PG8_STAGE(PG8_SA(1, 1), a1 + hstep, voffA);
            PG8_WAIT_L(8); PG8_BAR; PG8_WAIT_L(0); PG8_MMA(0, 0, At, B0); PG8_BAR; PG8_SCHED;
            PG8_LDB(B1, 0, 1); PG8_STAGE(PG8_SB(0, 0), b2, voffB);
            PG8_BAR; PG8_WAIT_L(0); PG8_MMA(0, 1, At, B1); PG8_BAR;
            PG8_LDA(At, 0, 1); PG8_STAGE(PG8_SA(0, 0), a2, voffA);
            PG8_BAR; PG8_WAIT_L(0); PG8_MMA(1, 0, At, B0); PG8_BAR; PG8_SCHED;
            PG8_STAGE(PG8_SB(0, 1), b2 + hstep, voffB);
            PG8_WAIT_V(6); PG8_BAR; PG8_MMA(1, 1, At, B1); PG8_BAR;
            PG8_LDB(B0, 1, 0); PG8_SCHED; PG8_LDA(At, 1, 0); PG8_STAGE(PG8_SA(0, 1), a2 + hstep, voffA);
            PG8_WAIT_L(8); PG8_BAR; PG8_WAIT_L(0); PG8_MMA(0, 0, At, B0); PG8_BAR; PG8_SCHED;
            PG8_LDB(B1, 1, 1); PG8_STAGE(PG8_SB(1, 0), b3, voffB);
            PG8_BAR; PG8_WAIT_L(0); PG8_MMA(0, 1, At, B1); PG8_BAR;
            PG8_LDA(At, 1, 1); PG8_STAGE(PG8_SA(1, 0), a3, voffA);
            PG8_BAR; PG8_WAIT_L(0); PG8_MMA(1, 0, At, B0); PG8_BAR; PG8_SCHED;
            PG8_STAGE(PG8_SB(1, 1), b3 + hstep, voffB);
            PG8_WAIT_V(6); PG8_BAR; PG8_MMA(1, 1, At, B1); PG8_BAR;
            }
        }
        if constexpr (ALIGN_EPI) { if (wr == 0) PG8_BAR; }
        if constexpr (!Epi::AFTER_DRAIN) { E(acc, cur, wr, wc, fr, fq); S.done(cur); }
        if (!has_next) break;
#pragma unroll
        for (int a = 0; a < 2; ++a)
#pragma unroll
            for (int b = 0; b < 2; ++b)
#pragma unroll
                for (int m = 0; m < 4; ++m)
#pragma unroll
                    for (int n = 0; n < 2; ++n) acc[a][b][m][n] = (f32x4){0.f, 0.f, 0.f, 0.f};
        cur = nxt; cA = nA; cB = nB; ++ui;
        if constexpr (ALIGN_EPI) { if (wr == 1) PG8_BAR; }
    }
    PG8_WAIT_V(0);
    if constexpr (!ALIGN_EPI) { if (wr == 0) PG8_BAR; }
    PG8_BAR;
    if constexpr (Epi::AFTER_DRAIN) { E.fused(acc, cur, wr, wc, fr, fq, lds, wid, lane); S.done(cur); }
#undef PG8_SA
#undef PG8_SB
#undef PG8_STAGE
#undef PG8_LDA
#undef PG8_LDB
#undef PG8_MMA
#undef PG8_WAIT_V
#undef PG8_WAIT_L
#undef PG8_BAR
#undef PG8_SCHED
}
}
namespace cg = cooperative_groups;
#define LAS __attribute__((address_space(3)))
#define GAS __attribute__((address_space(1)))
typedef unsigned short bf16;
typedef unsigned v4u __attribute__((ext_vector_type(4)));
typedef unsigned v2u __attribute__((ext_vector_type(2)));
typedef float f32x4 __attribute__((ext_vector_type(4)));
typedef float f32x16 __attribute__((ext_vector_type(16)));
typedef short bf16x8 __attribute__((ext_vector_type(8)));
typedef short s16x4 __attribute__((ext_vector_type(4)));
typedef float f32x2_t __attribute__((ext_vector_type(2)));
typedef __bf16 bf16x2_t __attribute__((ext_vector_type(2)));

constexpr int DM = 2048, DI = 4096, SEQ = 4096, ML = 16384, MC = 1024, MT = ML + MC;
constexpr float EPS = 1e-6f, LOG2E = 1.4426950408889634f;
constexpr float LAM_INIT1 = 0.35550906f;
constexpr int NWAVES = 8, NPH = 21;
constexpr int LDS_BYTES = 147456, LDS_BARST = LDS_BYTES - 64;

constexpr size_t MiB = 1u << 20;
constexpr size_t WS_MOD = 0, MOD_ZERO_BYTES = 512 * 1024;
constexpr size_t WS_BAR = 496 * 1024;
constexpr size_t WS_TAB = 1 * MiB;
constexpr size_t WS_WTIN = 2 * MiB, WS_WTOUT = 66 * MiB;
constexpr size_t WS_HA = 82 * MiB;
constexpr size_t WS_CBUF = 150 * MiB;
constexpr size_t WS_SLOT = 160 * MiB, SLOT_BYTES = 136 * MiB;
constexpr size_t WS_SLAB = WS_SLOT + 4 * SLOT_BYTES;
constexpr size_t WS_HALO = WS_SLAB + 64 * MiB;
constexpr size_t WS_END = WS_HALO + 8 * MiB;

__device__ __forceinline__ unsigned f2bf(float f) { unsigned u = __builtin_bit_cast(unsigned, f); return (u + 0x7fffu + ((u >> 16) & 1u)) >> 16; }
__device__ __forceinline__ unsigned pk2(float lo, float hi) { f32x2_t v = {lo, hi}; bf16x2_t b = __builtin_convertvector(v, bf16x2_t); return __builtin_bit_cast(unsigned, b); }
__device__ __forceinline__ float bflo(unsigned w) { return __builtin_bit_cast(float, w << 16); }
__device__ __forceinline__ float bfhi(unsigned w) { return __builtin_bit_cast(float, w & 0xffff0000u); }
__device__ __forceinline__ float wave_sum(float v) {
#pragma unroll
    for (int o = 1; o < 64; o <<= 1) v += __shfl_xor(v, o);
    return v;
}
__device__ __forceinline__ float wave_max(float v) {
#pragma unroll
    for (int o = 1; o < 64; o <<= 1) v = fmaxf(v, __shfl_xor(v, o));
    return v;
}
#define LDS_WAIT() asm volatile("s_waitcnt lgkmcnt(0)" ::: "memory")
__device__ __forceinline__ int crow(int r, int hi) { return (r & 3) + 8 * (r >> 2) + 4 * hi; }

enum { MAP_ID = 0, MAP_P32 = 1, MAP_CONV = 2, MAP_DIFF = 3, MAP_WIN = 4 };
template <int MAP> __device__ __forceinline__ int colmap(int slot) {
    if (MAP == MAP_ID) return slot;
    if (MAP == MAP_P32) return (slot & ~31) + pg8::perm32(slot & 31);
    const int pn = slot >> 8, s = slot & 255, bj = s >> 7, wc = (s >> 5) & 3, n = (s >> 4) & 1, q = s & 15;
    if (MAP == MAP_WIN) return pn < 20 ? pn * 256 + 64 * wc + 32 * bj + 16 * n + q : (slot & ~31) + pg8::perm32(slot & 31);
    if (MAP == MAP_DIFF) return pn < 32 ? pn * 256 + 64 * wc + 32 * bj + 16 * n + q : (slot & ~31) + pg8::perm32(slot & 31);
    return (2 * bj + n) * 4096 + 64 * pn + 16 * wc + q;
}
template <int MAP> __device__ __forceinline__ void transpose_item(const float* W, int K, int N, bf16* WT, LAS float* scr, int item, int lane) {
    const int nblk = N / 32, kb = item / nblk, nb = item % nblk, k0 = 64 * kb, n0 = 32 * nb;
    const int col = colmap<MAP>(n0 + (lane & 31));
    float tv[32];
#pragma unroll
    for (int i = 0; i < 32; ++i) { const int kk = 2 * i + (lane >> 5); tv[i] = ((const GAS float*)W)[(size_t)(k0 + kk) * N + col]; }
#pragma unroll
    for (int i = 0; i < 32; ++i) { const int kk = 2 * i + (lane >> 5); scr[kk * 33 + (lane & 31)] = tv[i]; }
    LDS_WAIT();
    const int c = lane & 7;
#pragma unroll
    for (int j = 0; j < 4; ++j) { const int n = (lane >> 3) + 8 * j; const LAS float* s = scr + (8 * c) * 33 + n;
        v4u o; o.x = pk2(s[0 * 33], s[1 * 33]); o.y = pk2(s[2 * 33], s[3 * 33]); o.z = pk2(s[4 * 33], s[5 * 33]); o.w = pk2(s[6 * 33], s[7 * 33]);
        *(GAS v4u*)(WT + (size_t)(n0 + n) * K + k0 + 8 * c) = o; }
    LDS_WAIT();
}
template <int MAP> __device__ __forceinline__ void transpose_all(const float* W, int K, int N, bf16* WT, LAS float* scr, int gw, int NGW, int lane) {
    const int items = (K / 64) * (N / 32);
    for (int it = gw; it < items; it += NGW) transpose_item<MAP>(W, K, N, WT, scr, it, lane);
}

struct Args { const float* in[38]; float* out; unsigned char* ws; int ph_lo, ph_hi; };
__device__ __forceinline__ const float* argp(int i) { const char* k = (const char*)__builtin_amdgcn_kernarg_segment_ptr(); asm volatile("" : "+s"(k)); const float* p = *(const float* const*)(k + 8 * i); return (const float*)(const GAS float*)p; }

__device__ __forceinline__ void mod_item(float* mod, LAS float* scr, int it, int lane) {
    const int l = it / 1536, r = it % 1536, kc = r / 96, cb = r % 96, k0 = kc * 128, col = cb * 64 + lane;
    const float* Wm = argp(l == 0 ? 5 : l == 1 ? 12 : l == 2 ? 24 : 32);
    const float* bm = argp(l == 0 ? 6 : l == 1 ? 13 : l == 2 ? 25 : 33);
    const float* c = argp(1); const float* cc = argp(3);
#pragma unroll
    for (int j = 0; j < 2; ++j) { const int kk = lane + 64 * j;
#pragma unroll
        for (int bi = 0; bi < 5; ++bi) { const float cv = bi < 4 ? c[bi * 2048 + k0 + kk] : cc[k0 + kk]; scr[bi * 128 + kk] = cv / (1.0f + __expf(-cv)); } }
    LDS_WAIT();
    float acc[5] = {0.f, 0.f, 0.f, 0.f, 0.f};
    const float* wp = Wm + (size_t)k0 * 6144 + col;
#pragma unroll 32
    for (int kk = 0; kk < 128; ++kk) { const float w = ((const GAS float*)wp)[(size_t)kk * 6144];
#pragma unroll
        for (int bi = 0; bi < 5; ++bi) acc[bi] += scr[bi * 128 + kk] * w; }
    if (kc == 0) { const float b = bm[col];
#pragma unroll
        for (int bi = 0; bi < 5; ++bi) acc[bi] += b; }
#pragma unroll
    for (int bi = 0; bi < 5; ++bi) atomicAdd(mod + (size_t)(l * 5 + bi) * 6144 + col, acc[bi]);
    LDS_WAIT();
}

__device__ __forceinline__ void norm_row(const float* src, const float* g, const float* md, bf16* dst, int lane, const float* slab = nullptr, const float* gate = nullptr, float* upd = nullptr) {
    const GAS f32x4* xr = (const GAS f32x4*)src + lane;
    f32x4 v[8]; float s = 0.f;
#pragma unroll
    for (int j = 0; j < 8; ++j) v[j] = xr[64 * j];
    if (slab) {
#pragma unroll
        for (int j = 0; j < 8; ++j) { f32x4 a = {0.f, 0.f, 0.f, 0.f};
#pragma unroll
            for (int ks = 0; ks < 8; ++ks) a += *((const GAS f32x4*)(slab + (size_t)ks * 1024 * 2048) + 64 * j + lane);
            v[j] += a * *((const GAS f32x4*)gate + 64 * j + lane); *((GAS f32x4*)upd + 64 * j + lane) = v[j]; }
    }
#pragma unroll
    for (int j = 0; j < 8; ++j) s += (v[j].x * v[j].x + v[j].y * v[j].y) + (v[j].z * v[j].z + v[j].w * v[j].w);
    const float rstd = 1.0f / sqrtf(wave_sum(s) * (1.0f / 2048.0f) + EPS);
#pragma unroll
    for (int j = 0; j < 8; ++j) { const int col = 256 * j + 4 * lane;
        const f32x4 g4 = *(const GAS f32x4*)(g + col), sh = *(const GAS f32x4*)(md + col), sc = *(const GAS f32x4*)(md + 2048 + col);
        const f32x4 y = (v[j] * rstd) * g4 * (sc + 1.0f) + sh;
        v2u o; o.x = pk2(y.x, y.y); o.y = pk2(y.z, y.w); *(GAS v2u*)(dst + col) = o; }
}

__device__ __forceinline__ void conv_item(const bf16* U, const bf16* BZ, bf16* Gd, const float* cw, const float* cb, int item, int tid) {
    const int r0 = 16 * item, col = 8 * tid;
    int s0, s1; if (r0 < ML) { s0 = r0 & ~4095; s1 = s0 + 4096; } else { s0 = ML + ((r0 - ML) & ~255); s1 = s0 + 256; }
    float w0[8], w1[8], w2[8], bb[8];
#pragma unroll
    for (int h = 0; h < 2; ++h) { const f32x4 a = *(const f32x4*)(cw + col + 4 * h), b = *(const f32x4*)(cw + 4096 + col + 4 * h), c = *(const f32x4*)(cw + 8192 + col + 4 * h), d = *(const f32x4*)(cb + col + 4 * h);
#pragma unroll
        for (int e = 0; e < 4; ++e) { w0[4 * h + e] = a[e]; w1[4 * h + e] = b[e]; w2[4 * h + e] = c[e]; bb[4 * h + e] = d[e]; } }
    const v4u zero = {0u, 0u, 0u, 0u};
    v4u prev = (r0 > s0) ? *(const GAS v4u*)(U + (size_t)(r0 - 1) * 4096 + col) : zero;
    v4u cur = *(const GAS v4u*)(U + (size_t)r0 * 4096 + col);
#pragma unroll 4
    for (int i = 0; i < 16; ++i) { const int r = r0 + i;
        const v4u nxt = (r + 1 < s1) ? *(const GAS v4u*)(U + (size_t)(r + 1) * 4096 + col) : zero;
        const v4u bz = *(const GAS v4u*)(BZ + (size_t)r * 4096 + col);
        v4u o;
#pragma unroll
        for (int w = 0; w < 4; ++w) {
            const float y0 = w0[2 * w] * bflo(prev[w]) + w1[2 * w] * bflo(cur[w]) + w2[2 * w] * bflo(nxt[w]) + bb[2 * w];
            const float y1 = w0[2 * w + 1] * bfhi(prev[w]) + w1[2 * w + 1] * bfhi(cur[w]) + w2[2 * w + 1] * bfhi(nxt[w]) + bb[2 * w + 1];
            o[w] = pk2(bflo(bz[w]) * y0, bfhi(bz[w]) * y1); }
        *(GAS v4u*)(Gd + (size_t)r * 4096 + col) = o;
        prev = cur; cur = nxt; }
}

__device__ __forceinline__ void convfix_item(bf16* Gd, const float* H, const float* cw, int ntiles, int item, int tid) {
    const int pm = item >> 1, sd = item & 1, col = 8 * tid;
    if (pm >= 64) return;
    if (sd == 0 ? (pm & 15) == 0 : (pm & 15) == 15) return;
    const size_t hs = (size_t)ntiles * 2 * 4096;
    const float* h = H + ((size_t)pm * 2 + sd) * 4096 + col;
    const float* hn = H + ((size_t)(sd ? pm + 1 : pm - 1) * 2 + (sd ? 0 : 1)) * 4096 + col;
    const float* w = cw + (sd ? 8192 : 0) + col;
    v4u o;
#pragma unroll
    for (int hh = 0; hh < 2; ++hh) { const f32x4 un = *(const GAS f32x4*)(hn + 4 * hh), yp = *(const GAS f32x4*)(h + hs + 4 * hh), bz = *(const GAS f32x4*)(h + 2 * hs + 4 * hh), ww = *(const GAS f32x4*)(w + 4 * hh);
        const f32x4 g = bz * (yp + ww * un); o[2 * hh] = pk2(g[0], g[1]); o[2 * hh + 1] = pk2(g[2], g[3]); }
    *(GAS v4u*)(Gd + ((size_t)pm * 256 + (sd ? 255 : 0)) * 4096 + col) = o;
}

template <int HD> __device__ __forceinline__ void qknorm_item(bf16* X, int ld, int item, const v4u raw, const float* gain, float oscale, const float2* tab, int lane) {
    constexpr int LPH = HD / 8, NF = HD / 4;
    const int parts = ld / 512, row = item / parts, part = item % parts, col = (part * 64 + lane) * 8, d0 = col % HD;
    bf16* p = X + (size_t)row * ld + col;
    float v[8];
#pragma unroll
    for (int w = 0; w < 4; ++w) { v[2 * w] = bflo(raw[w]); v[2 * w + 1] = bfhi(raw[w]); }
    float ss = 0.f;
#pragma unroll
    for (int e = 0; e < 8; ++e) ss += v[e] * v[e];
#pragma unroll
    for (int o = 1; o < LPH; o <<= 1) ss += __shfl_xor(ss, o);
    const float rstd = 1.0f / sqrtf(ss * (1.0f / HD) + EPS);
#pragma unroll
    for (int e = 0; e < 8; ++e) v[e] = v[e] * rstd * gain[d0 + e];
    float pv[8];
#pragma unroll
    for (int e = 0; e < 8; ++e) pv[e] = __shfl_xor(v[e], LPH / 4);
    if (row < ML) {
        const int t = row & 4095, axis = d0 / (HD / 2), half = (d0 / NF) & 1, f0 = d0 % NF, pos = axis ? (t & 63) : (t >> 6);
        const float2* cs = tab + pos * NF + f0;
#pragma unroll
        for (int e = 0; e < 8; ++e) { const float2 c = cs[e]; v[e] = half ? (pv[e] * c.y + v[e] * c.x) : (v[e] * c.x - pv[e] * c.y); }
    }
    v4u o;
#pragma unroll
    for (int w = 0; w < 4; ++w) o[w] = pk2(v[2 * w] * oscale, v[2 * w + 1] * oscale);
    *(GAS v4u*)p = o;
}
template <int HD> __device__ __forceinline__ void qknorm_all(bf16* X, int ld, int nitems, const float* gain, float oscale, const float2* tab, int gw, int NGW, int lane) {
    const int parts = ld / 512;
    for (int it = gw * 4; it < nitems; it += NGW * 4) {
        v4u raw[4];
#pragma unroll
        for (int j = 0; j < 4; ++j) { const int item = it + j, row = item / parts, part = item % parts; raw[j] = *(const GAS v4u*)(X + (size_t)row * ld + (part * 64 + lane) * 8); }
#pragma unroll
        for (int j = 0; j < 4; ++j) qknorm_item<HD>(X, ld, it + j, raw[j], gain, oscale, tab, lane);
    }
}

__device__ __forceinline__ s16x4 vtr(const LAS unsigned char* p) { typedef short v4i16_t __attribute__((ext_vector_type(4))); return __builtin_bit_cast(s16x4, __builtin_amdgcn_ds_read_tr16_b64_v4i16((LAS v4i16_t*)p)); }
template <bool DIFF, int VAR = 0>
__device__ __forceinline__ void attn_phase(LAS unsigned char* lds, const bf16* Q, bf16* O, const bf16* K, const bf16* V, const bf16* Z, const int ldk,
                                           const float shift2, const float lam, const float* subnorm, const float* sink, const float oscale, const int G, const int vcu) {
    int tid_ = threadIdx.x; asm volatile("" : "+v"(tid_));
    const int tid = tid_, lane = tid & 63, wid = __builtin_amdgcn_readfirstlane(tid >> 6), r32 = lane & 31, hi = lane >> 5;
    constexpr int KSTR = 272, VSTR = 320, KBYTES = 64 * KSTR, STAGE = KBYTES + 64 * VSTR, XOFF = 0, WSOFF = 3 * STAGE;
    static_assert(WSOFF + 8 * 128 <= LDS_BARST && 65536 <= 3 * STAGE, "attention LDS map");
    constexpr int DSTEPS = DIFF ? 4 : 8;
    const int nunits = DIFF ? 128 * 34 : 2048;
    const int skey = tid >> 4, scc = tid & 15;
    LAS float* wsf = (LAS float*)(lds + WSOFF) + wid * 32;
    const int vrow = 4 * hi + ((lane & 15) >> 2), vcol = 16 * ((lane >> 4) & 1) + 4 * (lane & 3);
    for (int u = vcu, ui = 0; u < nunits; u += G, ++ui) {
        int nlat, lat0, ctx0, koff, myq0, qcol0, kd0, zcol0, kt0 = 0, qpos = 0, qb_ = 0; float sinkv = 0.f;
        if (DIFF) {
            int bh, qi; if (u < 4096) { bh = u >> 5; qi = u & 31; } else { bh = (u - 4096) >> 1; qi = 32 + ((u - 4096) & 1); }
            const int b = bh >> 5, h = bh & 31, m = wid >> 2, qs = wid & 3; (void)ui;
            int qrow0; if (qi < 32) { qrow0 = b * 4096 + 128 * qi; nlat = 64; } else { qrow0 = ML + b * 256 + 128 * (qi - 32); nlat = 0; }
            lat0 = b * 4096; ctx0 = ML + b * 256; koff = h * 128; myq0 = qrow0 + 32 * qs; qcol0 = h * 128 + 64 * m; kd0 = 64 * m; zcol0 = h * 128;
        } else {
            const int b = u >> 9, kvh = (u >> 6) & 7, qb = u & 63, g = wid >> 1, qs = wid & 1, head = kvh * 4 + g;
            kt0 = qb - 2 < 0 ? 0 : qb - 2; const int kt1 = qb + 2 > 63 ? 63 : qb + 2; nlat = kt1 - kt0 + 1;
            lat0 = b * 4096 + 64 * kt0; ctx0 = ML + b * 256; koff = kvh * 128; myq0 = b * 4096 + 64 * qb + 32 * qs; qcol0 = head * 128; kd0 = 0; zcol0 = head * 128;
            qpos = 64 * qb + 32 * qs + r32; sinkv = sink[head]; qb_ = qb;
        }
        const int nt = nlat + 4;
        bf16x8 qf[DSTEPS];
#pragma unroll
        for (int d = 0; d < DSTEPS; ++d) qf[d] = *(const GAS bf16x8*)(Q + (size_t)(myq0 + r32) * 4096 + qcol0 + 16 * d + 8 * hi);
        f32x16 o[4];
#pragma unroll
        for (int e = 0; e < 4; ++e)
#pragma unroll
            for (int r = 0; r < 16; ++r) o[e][r] = 0.f;
        float lsum = 0.f;
        v4u kreg[2], vreg[2];
#define ATT_TROW(tt) (((tt) < nlat) ? lat0 + 64 * (tt) : ctx0 + 64 * ((tt) - nlat))
#define ATT_LOAD(tt) do { const int r0_ = ATT_TROW(tt); _Pragma("unroll") for (int i = 0; i < 2; ++i) { const size_t go = (size_t)(r0_ + skey + 32 * i) * ldk + koff + 8 * scc; kreg[i] = *(const GAS v4u*)(K + go); vreg[i] = *(const GAS v4u*)(V + go); } } while (0)
#define ATT_WRITE(so) do { _Pragma("unroll") for (int i = 0; i < 2; ++i) { *(LAS v4u*)(lds + (so) + (skey + 32 * i) * KSTR + scc * 16) = kreg[i]; *(LAS v4u*)(lds + (so) + KBYTES + (skey + 32 * i) * VSTR + scc * 16) = vreg[i]; } } while (0)
#define ATT_QK(S0_, S1_, so) do { const LAS unsigned char* kp_ = lds + (so) + r32 * KSTR + (kd0 + 8 * hi) * 2; \
            _Pragma("unroll") for (int r = 0; r < 16; ++r) { S0_[r] = -shift2; S1_[r] = -shift2; } \
            _Pragma("unroll") for (int d = 0; d < DSTEPS; ++d) { const bf16x8 k0_ = *(const LAS bf16x8*)(kp_ + d * 32), k1_ = *(const LAS bf16x8*)(kp_ + 32 * KSTR + d * 32); \
                S0_ = __builtin_amdgcn_mfma_f32_32x32x16_bf16(k0_, qf[d], S0_, 0, 0, 0); S1_ = __builtin_amdgcn_mfma_f32_32x32x16_bf16(k1_, qf[d], S1_, 0, 0, 0); \
                } } while (0)
        ATT_LOAD(0); ATT_WRITE(0); ATT_LOAD(1); ATT_WRITE(STAGE); ATT_LOAD(2);
        __syncthreads();
        f32x16 s0, s1, n0, n1;
        constexpr bool PIPE = DIFF;
        if (PIPE) ATT_QK(s0, s1, 0);
        int so_c = 0, so_n = STAGE, so_w = 2 * STAGE;
        for (int t = 0; t < nt; ++t) {
            if (VAR != 2) { ATT_WRITE(so_w); const int tl = t + 3 < nt ? t + 3 : nt - 1; ATT_LOAD(tl); } __builtin_amdgcn_sched_barrier(0);
            if (PIPE) { const int so_q = t + 1 < nt ? so_n : so_c; ATT_QK(n0, n1, so_q); }
            else ATT_QK(s0, s1, so_c);
#pragma unroll
            for (int r = 0; r < 16; ++r) { if (VAR == 1) { s0[r] = s0[r] * 1.0001f + 0.5f; s1[r] = s1[r] * 1.0001f + 0.5f; } else { s0[r] = __builtin_amdgcn_exp2f(s0[r]); s1[r] = __builtin_amdgcn_exp2f(s1[r]); } }
            if (!DIFF && t < nlat && (kt0 + t == qb_ - 2 || kt0 + t == qb_ + 2)) { const int lim = 128; const int kb0 = 64 * (kt0 + t) - qpos;
#pragma unroll
                for (int r = 0; r < 16; ++r) { const int dd = kb0 + crow(r, hi); if (dd < -lim || dd > lim) s0[r] = 0.f; if (dd + 32 < -lim || dd + 32 > lim) s1[r] = 0.f; } }
            { float a = 0.f, b = 0.f;
#pragma unroll
              for (int r = 0; r < 16; ++r) { a += s0[r]; b += s1[r]; }
              lsum += a + b; }
            const LAS unsigned char* vp = lds + so_c + KBYTES + vrow * VSTR + vcol * 2;
#pragma unroll
            for (int kb = 0; kb < 2; ++kb)
#pragma unroll
                for (int sp = 0; sp < 2; ++sp) {
                    v4u pw;
#pragma unroll
                    for (int w = 0; w < 4; ++w) pw[w] = kb == 0 ? pk2(s0[8 * sp + 2 * w], s0[8 * sp + 2 * w + 1]) : pk2(s1[8 * sp + 2 * w], s1[8 * sp + 2 * w + 1]);
                    const bf16x8 pa = __builtin_bit_cast(bf16x8, pw);
#pragma unroll
                    for (int eb = 0; eb < 4; ++eb) {
                        bf16x8 vb;
                        if (VAR == 3) { vb = qf[(kb * 2 + sp + eb) & 3]; }
                        else { const s16x4 lo = vtr(vp + (32 * kb + 16 * sp) * VSTR + 64 * eb), hh = vtr(vp + (32 * kb + 16 * sp + 8) * VSTR + 64 * eb);
                        vb = (bf16x8){lo[0], lo[1], lo[2], lo[3], hh[0], hh[1], hh[2], hh[3]}; }
                        o[eb] = __builtin_amdgcn_mfma_f32_32x32x16_bf16(pa, vb, o[eb], 0, 0, 0); } }
            if (VAR != 4) __syncthreads();
            if (PIPE) { s0 = n0; s1 = n1; }
            { const int tmp = so_c; so_c = so_n; so_n = so_w; so_w = tmp; }
        }
#undef ATT_TROW
#undef ATT_LOAD
#undef ATT_WRITE
#undef ATT_QK
        float lt = lsum + __shfl_xor(lsum, 32);
        if (!DIFF) lt += __builtin_amdgcn_exp2f(sinkv * LOG2E - shift2);
        if (hi == 0) wsf[r32] = lt;
        LDS_WAIT();
        float rl[16];
#pragma unroll
        for (int r = 0; r < 16; ++r) rl[r] = 1.0f / wsf[crow(r, hi)];
        LDS_WAIT();
        if (DIFF) {
            LAS float* X = (LAS float*)(lds + XOFF) + (wid & 3) * 4096 + lane;
            if (wid >= 4) {
#pragma unroll
                for (int eb = 0; eb < 4; ++eb)
#pragma unroll
                    for (int r = 0; r < 16; ++r) X[(eb * 16 + r) * 64] = o[eb][r] * rl[r] * lam;
            }
            __syncthreads();
            if (wid < 4) {
                float ssq[16];
#pragma unroll
                for (int r = 0; r < 16; ++r) ssq[r] = 0.f;
#pragma unroll
                for (int eb = 0; eb < 4; ++eb)
#pragma unroll
                    for (int r = 0; r < 16; ++r) { const float v = o[eb][r] * rl[r] - X[(eb * 16 + r) * 64]; o[eb][r] = v; ssq[r] += v * v; }
#pragma unroll
                for (int r = 0; r < 16; ++r) { float s = ssq[r];
#pragma unroll
                    for (int of = 1; of < 32; of <<= 1) s += __shfl_xor(s, of);
                    ssq[r] = oscale / sqrtf(s * (1.0f / 128.0f) + EPS); }
#pragma unroll
                for (int eb = 0; eb < 4; ++eb) { const float gn = subnorm[32 * eb + r32];
                    unsigned zz[16];
#pragma unroll
                    for (int r = 0; r < 16; ++r) zz[r] = (unsigned)((const GAS bf16*)Z)[(size_t)(myq0 + crow(r, hi)) * 4096 + zcol0 + 32 * eb + r32];
#pragma unroll
                    for (int r = 0; r < 16; ++r) { const size_t off = (size_t)(myq0 + crow(r, hi)) * 4096 + zcol0 + 32 * eb + r32;
                        ((GAS bf16*)O)[off] = (bf16)f2bf(o[eb][r] * ssq[r] * gn * pg8::silu_f(bflo(zz[r]))); } }
            }
            __syncthreads();
        } else {
#pragma unroll
            for (int eb = 0; eb < 4; ++eb) { unsigned zz[16];
#pragma unroll
                for (int r = 0; r < 16; ++r) zz[r] = (unsigned)((const GAS bf16*)Z)[(size_t)(myq0 + crow(r, hi)) * 4096 + zcol0 + 32 * eb + r32];
#pragma unroll
                for (int r = 0; r < 16; ++r) { const size_t off = (size_t)(myq0 + crow(r, hi)) * 4096 + zcol0 + 32 * eb + r32;
                    ((GAS bf16*)O)[off] = (bf16)f2bf(o[eb][r] * rl[r] * pg8::silu_f(bflo(zz[r]))); } }
        }
    }
}

#define RLX_AGENT __ATOMIC_RELAXED, __HIP_MEMORY_SCOPE_AGENT
#define XB_TMO      128
#define XB_XCNT(j)  (256  + 64 * (j))
#define XB_XSUB(j)  (1280 + 64 * (j))
#define XB_XGEN(j)  (2304 + 64 * (j))
#define XB_TOP      3328
#define XB_TOPGEN   3392
#define XCD_BAR_WORDS 3456
#define XB_SPIN_CAP (1u << 18)

__device__ __forceinline__ unsigned xb_ld(unsigned* p)              { return __hip_atomic_load(p, __ATOMIC_RELAXED, __HIP_MEMORY_SCOPE_AGENT); }
__device__ __forceinline__ unsigned xb_add(unsigned* p, unsigned v) { return __hip_atomic_fetch_add(p, v, __ATOMIC_RELAXED, __HIP_MEMORY_SCOPE_AGENT); }
__device__ __forceinline__ unsigned xb_xcc_id() { return (unsigned)__builtin_amdgcn_s_getreg((3 << 11) | 20) & 0xFu; }
#define XB_SPIN(cond, bar) do { unsigned _sp = 0; while (cond) { __builtin_amdgcn_s_sleep(1); \
    if ((++_sp & 255u) == 0u) { if (xb_ld(&(bar)[XB_TMO])) break; if (_sp > XB_SPIN_CAP) { atomicAdd(&(bar)[XB_TMO], 1u); break; } } } } while (0)

struct XcdBarrier {
    unsigned* bar; unsigned x;
    volatile LAS unsigned* st;
};

__device__ __forceinline__ XcdBarrier xcd_barrier_post(unsigned* bar, volatile LAS unsigned* st) {
    XcdBarrier b; b.bar = bar; b.x = xb_xcc_id(); b.st = st;
    if (threadIdx.x == 0) (void)xb_add(&bar[XB_XCNT(b.x)], 1u);
    return b;
}
__device__ __forceinline__ void xcd_barrier_complete(unsigned* bar, unsigned x, unsigned& nloc, unsigned& nx) {
    const unsigned G = gridDim.x * gridDim.y * gridDim.z;
    unsigned sum, cnt, mine, sp = 0u;
    for (;;) {
        sum = 0u; cnt = 0u; mine = 0u;
#pragma unroll
        for (unsigned j = 0; j < 16; ++j) { const unsigned c = xb_ld(&bar[XB_XCNT(j)]); sum += c; cnt += (c > 0u) ? 1u : 0u; mine = (j == x) ? c : mine; }
        if (sum == G) break;
        __builtin_amdgcn_s_sleep(1);
        if ((++sp & 255u) == 0u) { if (xb_ld(&bar[XB_TMO])) break; if (sp > XB_SPIN_CAP) { atomicAdd(&bar[XB_TMO], 1u); break; } }
    }
    nloc = mine > 0u ? mine : 1u; nx = cnt > 0u ? cnt : 1u;
}

__device__ __forceinline__ void xcd_barrier(const XcdBarrier& b) {
    asm volatile("s_waitcnt vmcnt(0)" ::: "memory");
    __syncthreads();
    if (threadIdx.x == 0) {
        unsigned* bar = b.bar;
        __builtin_amdgcn_s_waitcnt(0);
        unsigned nloc = b.st[0], nx = b.st[1];
        if (nloc == 0u) { xcd_barrier_complete(bar, b.x, nloc, nx); b.st[0] = nloc; b.st[1] = nx; }
        const unsigned old = xb_add(&bar[XB_XSUB(b.x)], 1u);
        const unsigned gen = old / nloc;
        if (old + 1u == (gen + 1u) * nloc) {
            __builtin_amdgcn_fence(__ATOMIC_RELEASE, "agent");
            asm volatile("s_waitcnt vmcnt(0)" ::: "memory");
            const unsigned og = xb_add(&bar[XB_TOP], 1u);
            const unsigned tg = og / nx;
            if (og + 1u == (tg + 1u) * nx) xb_add(&bar[XB_TOPGEN], 1u);
            else XB_SPIN(xb_ld(&bar[XB_TOPGEN]) == tg, bar);
            __builtin_amdgcn_fence(__ATOMIC_ACQUIRE, "agent");
            xb_add(&bar[XB_XGEN(b.x)], 1u);
            asm volatile("s_waitcnt vmcnt(0)" ::: "memory");
        } else {
            XB_SPIN(xb_ld(&bar[XB_XGEN(b.x)]) == gen, bar);
            __builtin_amdgcn_fence(__ATOMIC_ACQUIRE, "agent");
            asm volatile("s_waitcnt vmcnt(0)" ::: "memory");
        }
    }
    __syncthreads();
}

#ifndef G2_ALIGN
#define G2_ALIGN false
#endif
#ifndef MK_SINGLE
#define MK_SINGLE 1
#endif
__global__ void __launch_bounds__(NWAVES * 64, 2) mk_fwd(Args a) {
    extern __shared__ __attribute__((aligned(16))) unsigned char lds_raw[];
    LAS unsigned char* lds = (LAS unsigned char*)lds_raw;
    cg::grid_group grid = cg::this_grid();
    const int lo = a.ph_lo, hi = a.ph_hi;
#define PHASE_LOCALS \
    int tid_ = threadIdx.x; asm volatile("" : "+v"(tid_)); const int tid = tid_, lane = tid & 63, wave = __builtin_amdgcn_readfirstlane(tid >> 6); (void)lane; (void)wave; \
    int G_ = gridDim.x, bx_ = blockIdx.x; asm volatile("" : "+s"(G_), "+s"(bx_)); const int G = G_, bx = bx_, vcu = (G % 8 == 0) ? (bx % 8) * (G / 8) + bx / 8 : bx; \
    const int gw = vcu * NWAVES + wave, NGW = G * NWAVES; (void)gw; (void)NGW; \
    unsigned char* ws_ = a.ws; asm volatile("" : "+s"(ws_)); unsigned char* ws = (unsigned char*)(GAS unsigned char*)ws_; \
    float* mod = (float*)(ws + WS_MOD); float2* tab64 = (float2*)(ws + WS_TAB); float2* tab128 = tab64 + 64 * 16; (void)mod; (void)tab64; (void)tab128; \
    bf16* WTin = (bf16*)(ws + WS_WTIN); bf16* WTout = (bf16*)(ws + WS_WTOUT); bf16* HA = (bf16*)(ws + WS_HA); float* cbuf = (float*)(ws + WS_CBUF); (void)WTin; (void)WTout; (void)HA; (void)cbuf; \
    bf16* S0 = (bf16*)(ws + WS_SLOT); bf16* S1 = (bf16*)(ws + WS_SLOT + SLOT_BYTES); bf16* S2 = (bf16*)(ws + WS_SLOT + 2 * SLOT_BYTES); bf16* S3 = (bf16*)(ws + WS_SLOT + 3 * SLOT_BYTES); (void)S0; (void)S1; (void)S2; (void)S3; \
    LAS float* scr = (LAS float*)(lds + wave * 16384); (void)scr;
#define IN(k) (lo <= (k) && (k) < hi)
#define SEAM(k) do { if ((k) + 1 < hi) { if ((k) == 0) grid.sync(); else { unsigned char* wsb_ = a.ws; asm volatile("" : "+s"(wsb_)); XcdBarrier bar_; bar_.bar = (unsigned*)(wsb_ + WS_BAR); bar_.x = xb_xcc_id(); bar_.st = (volatile LAS unsigned*)(lds + LDS_BARST); xcd_barrier(bar_); } } } while (0)
    if (hi - lo > 1) {
        if (threadIdx.x < 2) ((volatile LAS unsigned*)(lds + LDS_BARST))[threadIdx.x] = 0u;
        __syncthreads();
        unsigned char* wsb_ = a.ws; (void)xcd_barrier_post((unsigned*)(wsb_ + WS_BAR), (volatile LAS unsigned*)(lds + LDS_BARST));
    }

    if (IN(0)) { PHASE_LOCALS
        transpose_all<MAP_CONV>(argp(7), DM, 4 * DI, WTin, scr, gw, NGW, lane);
        transpose_all<MAP_ID>(argp(10), DI, DM, WTout, scr, gw, NGW, lane);
#ifdef PROBE_DUP_TRANS
        transpose_all<MAP_CONV>(argp(7), DM, 4 * DI, WTin, scr, gw, NGW, lane);
        transpose_all<MAP_ID>(argp(10), DI, DM, WTout, scr, gw, NGW, lane);
#endif
        for (int it = gw; it < 6144; it += NGW) mod_item(mod, scr, it, lane);
        if (bx == 0) {
            for (int i = tid; i < 64 * 16; i += NWAVES * 64) { const int pos = i >> 4, f = i & 15; const float ang = (float)pos * exp2f(-(float)f * (13.287712379549449f / 16.0f)); tab64[i] = make_float2(cosf(ang), sinf(ang)); }
            for (int i = tid; i < 64 * 32; i += NWAVES * 64) { const int pos = i >> 5, f = i & 31; const float ang = (float)pos * exp2f(-(float)f * (13.287712379549449f / 32.0f)); tab128[i] = make_float2(cosf(ang), sinf(ang)); }
        }
        SEAM(0);
    }
#pragma unroll
    for (int l = 0; l < 4; ++l) {
        const int base = 1 + 5 * l, kind = (l == 3) ? 0 : l;
        const int LB = l == 0 ? 4 : l == 1 ? 11 : l == 2 ? 23 : 31, LW = l == 0 ? 10 : l == 1 ? 22 : l == 2 ? 30 : 37;
#define XCUR (l == 0 ? argp(0) : (const float*)(const GAS float*)a.out)
#define CCUR (l == 0 ? argp(2) : (const float*)cbuf)
        const int m1 = (l == 3) ? ML : MT;
        if (IN(base)) { PHASE_LOCALS
            if (l > 0) {
                if (kind == 0) transpose_all<MAP_CONV>(argp(LB + 3), DM, 4 * DI, WTin, scr, gw, NGW, lane);
                else if (kind == 1) transpose_all<MAP_DIFF>(argp(LB + 3), DM, 4 * DI, WTin, scr, gw, NGW, lane);
                else transpose_all<MAP_WIN>(argp(LB + 3), DM, 2 * DI + 2048, WTin, scr, gw, NGW, lane);
                transpose_all<MAP_ID>(argp(LW), DI, DM, WTout, scr, gw, NGW, lane);
            }
#ifdef PROBE_DUP_TRANS
            if (l > 0) {
                if (kind == 0) transpose_all<MAP_CONV>(argp(LB + 3), DM, 4 * DI, WTin, scr, gw, NGW, lane);
                else if (kind == 1) transpose_all<MAP_DIFF>(argp(LB + 3), DM, 4 * DI, WTin, scr, gw, NGW, lane);
                else transpose_all<MAP_WIN>(argp(LB + 3), DM, 2 * DI + 2048, WTin, scr, gw, NGW, lane);
                transpose_all<MAP_ID>(argp(LW), DI, DM, WTout, scr, gw, NGW, lane);
            }
#endif
            const float* xc = XCUR; const float* cc = CCUR; const float* ng = argp(LB);
            float* slab = (float*)(ws + WS_SLAB); (void)slab;
            for (int row = gw; row < m1; row += NGW) { const bool lat = row < ML;
                if (lat || l == 0) norm_row(lat ? xc + (size_t)row * DM : cc + (size_t)(row - ML) * DM, ng, mod + (size_t)(l * 5 + (lat ? (row >> 12) : 4)) * 6144, HA + (size_t)row * DM, lane);
                else { const float* prev = l == 1 ? argp(2) : (const float*)cbuf;
                    norm_row(prev + (size_t)(row - ML) * DM, ng, mod + (size_t)(l * 5 + 4) * 6144, HA + (size_t)row * DM, lane, slab + (size_t)(row - ML) * DM, mod + (size_t)((l - 1) * 5 + 4) * 6144 + 4096, cbuf + (size_t)(row - ML) * DM); } }
#ifdef PROBE_DUP_NORMCONV
            {
            const float* xc = XCUR; const float* cc = CCUR; const float* ng = argp(LB);
            float* slab = (float*)(ws + WS_SLAB); (void)slab;
            for (int row = gw; row < m1; row += NGW) { const bool lat = row < ML;
                if (lat || l == 0) norm_row(lat ? xc + (size_t)row * DM : cc + (size_t)(row - ML) * DM, ng, mod + (size_t)(l * 5 + (lat ? (row >> 12) : 4)) * 6144, HA + (size_t)row * DM, lane);
                else { const float* prev = l == 1 ? argp(2) : (const float*)cbuf;
                    norm_row(prev + (size_t)(row - ML) * DM, ng, mod + (size_t)(l * 5 + 4) * 6144, HA + (size_t)row * DM, lane, slab + (size_t)(row - ML) * DM, mod + (size_t)((l - 1) * 5 + 4) * 6144 + 4096, cbuf + (size_t)(row - ML) * DM); } }
            }
#endif
            SEAM(base);
        }
        if (IN(base + 1)) { PHASE_LOCALS
            if (kind == 0) { pg8::Gemm g{HA, WTin, m1, 4 * DI, DM}; pg8::StaticOrder S; S.init(m1, 4 * DI, G, bx); pg8::EpiConvF E{S2, (float*)(ws + WS_HALO), argp(LB + 4), argp(LB + 5), (LAS float*)(lds + 131072), m1 / 256};

#ifndef NO_G1C
                pg8::gemm_phase<pg8::EpiConvF, pg8::StaticOrder, true, true>(lds, g, S, E);
#ifdef PROBE_DUP_G1
                pg8::gemm_phase<pg8::EpiConvF, pg8::StaticOrder, true, true>(lds, g, S, E);
#endif
#endif
 }
            else if (kind == 1) { pg8::Gemm g{HA, WTin, m1, 4 * DI, DM}; pg8::StaticOrder S; S.init(m1, 4 * DI, G, bx); typedef pg8::EpiDiff<(long)(SLOT_BYTES / 2)> EpiS1; EpiS1 E{S0, argp(LB + 4), argp(LB + 5), (const float*)tab64, 0.125f * LOG2E};

#if !defined(NO_G1S) && !defined(NO_G1S1)
                pg8::gemm_phase<EpiS1, pg8::StaticOrder, true, true>(lds, g, S, E);
#ifdef PROBE_DUP_G1
                pg8::gemm_phase<EpiS1, pg8::StaticOrder, true, true>(lds, g, S, E);
#endif
#endif
 }
            else { pg8::Gemm g{HA, WTin, m1, 2 * DI + 2048, DM}; pg8::StaticOrder S; S.init(m1, 2 * DI + 2048, G, bx); typedef pg8::EpiWin<(long)(SLOT_BYTES / 2), (long)MT> EpiS2; EpiS2 E{S0, argp(LB + 4), argp(LB + 5), (const float*)tab128, 0.08838834764831845f * LOG2E, (LAS float*)(lds + 131072)};

#if !defined(NO_G1S) && !defined(NO_G1S2)
                pg8::gemm_phase<EpiS2, pg8::StaticOrder, true, true>(lds, g, S, E);
#ifdef PROBE_DUP_G1
                pg8::gemm_phase<EpiS2, pg8::StaticOrder, true, true>(lds, g, S, E);
#endif
#endif
 }
            SEAM(base + 1);
        }
        if (kind == 0 && IN(base + 2)) { PHASE_LOCALS
            if (kind == 0) { for (int it = bx; it < (m1 / 256) * 2; it += G) convfix_item(S2, (const float*)(ws + WS_HALO), argp(LB + 4), m1 / 256, it, tid); }
#ifdef PROBE_DUP_NORMCONV
            if (kind == 0) { for (int it = bx; it < (m1 / 256) * 2; it += G) convfix_item(S2, (const float*)(ws + WS_HALO), argp(LB + 4), m1 / 256, it, tid); }
#endif
            else if (kind == 1) {
                qknorm_all<64>(S0, DI, MT * 8, argp(LB + 4), 0.125f * LOG2E, tab64, gw, NGW, lane);
                qknorm_all<64>(S1, DI, MT * 8, argp(LB + 5), 1.0f, tab64, gw, NGW, lane);
            } else {
                qknorm_all<128>(S0, DI, ML * 8, argp(LB + 4), 0.08838834764831845f * LOG2E, tab128, gw, NGW, lane);
                qknorm_all<128>(S1, 1024, MT * 2, argp(LB + 5), 1.0f, tab128, gw, NGW, lane);
            }
            SEAM(base + 2);
        }
        if (kind != 0 && IN(base + 3)) { PHASE_LOCALS
            if (kind == 1) {
                const float gq = wave_max(fabsf(argp(LB + 4)[lane])), gk = wave_max(fabsf(argp(LB + 5)[lane]));
                const float d1 = wave_sum(argp(LB + 6)[lane] * argp(LB + 7)[lane]), d2 = wave_sum(argp(LB + 8)[lane] * argp(LB + 9)[lane]);
                const float lam = expf(d1) - expf(d2) + LAM_INIT1;
#ifndef NO_ATTN1
#ifdef PROBE_DUP_ATTN
                attn_phase<true, PROBE_DUP_ATTN - 1>(lds, S0, (bf16*)(ws + WS_END), S1, S2, S3, DI, 8.0f * gq * gk * LOG2E, lam, argp(LB + 10), nullptr, 1.0f - LAM_INIT1, G, vcu);
#endif
                attn_phase<true>(lds, S0, S0, S1, S2, S3, DI, 8.0f * gq * gk * LOG2E, lam, argp(LB + 10), nullptr, 1.0f - LAM_INIT1, G, vcu);
#endif
            } else {
                const float gq = wave_max(fmaxf(fabsf(argp(LB + 4)[lane]), fabsf(argp(LB + 4)[lane + 64]))), gk = wave_max(fmaxf(fabsf(argp(LB + 5)[lane]), fabsf(argp(LB + 5)[lane + 64])));
#ifndef NO_ATTN2
#ifdef PROBE_DUP_WATTN
                attn_phase<false>(lds, S0, (bf16*)(ws + WS_END), S1, S1 + (size_t)MT * 1024, S3, 1024, 11.313708498984761f * gq * gk * LOG2E, 0.f, nullptr, argp(LB + 6), 1.0f, G, vcu);
#endif
                attn_phase<false>(lds, S0, S0, S1, S1 + (size_t)MT * 1024, S3, 1024, 11.313708498984761f * gq * gk * LOG2E, 0.f, nullptr, argp(LB + 6), 1.0f, G, vcu);
#endif
            }
            SEAM(base + 3);
        }
        if (IN(base + 4)) { PHASE_LOCALS
            { pg8::Gemm g{kind == 0 ? S2 : S0, WTout, ML, DM, DI}; pg8::StaticOrder S; S.init(ML, DM, G, bx);
              pg8::EpiResid E{XCUR, (float*)(GAS float*)a.out, mod + (size_t)l * 5 * 6144};
              pg8::gemm_phase<pg8::EpiResid, pg8::StaticOrder, G2_ALIGN, true>(lds, g, S, E);
#ifdef PROBE_DUP_G2L0
              if (l == 0) pg8::gemm_phase<pg8::EpiResid, pg8::StaticOrder, G2_ALIGN, true>(lds, g, S, E);
#endif
            }
            if (l < 2) {
                pg8::Gemm g{kind == 0 ? S2 : S0, WTout, MT, DM, 512, DI}; pg8::SplitOrder S{bx, G}; pg8::EpiSlab E{(float*)(ws + WS_SLAB)};
#ifndef NO_SPLIT
                pg8::gemm_phase<pg8::EpiSlab, pg8::SplitOrder, true, true>(lds, g, S, E);
#endif
            }
            SEAM(base + 4);
        }
    }
#undef IN
#undef SEAM
}

extern "C" void kernel_launch(void* const* d_in, const int* in_sizes, int n_in, void* d_out, int out_size, void* d_ws, size_t ws_size, hipStream_t stream) {
    static int grid = 0;
    if (grid == 0) {
        if (n_in != 38 || in_sizes[0] != ML * DM || out_size != ML * DM || ws_size < WS_END) { fprintf(stderr, "kernel_launch: unexpected shapes (n_in %d, out %d, ws %zu < %zu)\n", n_in, out_size, ws_size, (size_t)WS_END); grid = -1; return; }
        int dev = 0, cus = 0, per_cu = 0;
        if (hipGetDevice(&dev) != hipSuccess || hipDeviceGetAttribute(&cus, hipDeviceAttributeMultiprocessorCount, dev) != hipSuccess) { grid = -1; return; }
        if (hipFuncSetAttribute((const void*)mk_fwd, hipFuncAttributeMaxDynamicSharedMemorySize, LDS_BYTES) != hipSuccess) { fprintf(stderr, "kernel_launch: hipFuncSetAttribute failed\n"); grid = -1; return; }
        if (hipOccupancyMaxActiveBlocksPerMultiprocessor(&per_cu, (const void*)mk_fwd, NWAVES * 64, LDS_BYTES) != hipSuccess || per_cu < 1) { fprintf(stderr, "kernel_launch: occupancy query says %d\n", per_cu); per_cu = 1; }
        (void)hipGetLastError();
        grid = cus;
    }
    if (grid < 0) return;
    (void)hipMemsetAsync((char*)d_ws + WS_MOD, 0, MOD_ZERO_BYTES, stream);
    Args a{};
    for (int i = 0; i < 38; ++i) a.in[i] = (const float*)d_in[i];
    a.out = (float*)d_out; a.ws = (unsigned char*)d_ws;
#if MK_SINGLE
    a.ph_lo = 0; a.ph_hi = NPH;
    void* params[] = {&a};
    const hipError_t e = hipLaunchCooperativeKernel((const void*)mk_fwd, dim3(grid), dim3(NWAVES * 64), params, LDS_BYTES, stream);
    if (e != hipSuccess) fprintf(stderr, "kernel_launch: cooperative launch failed: %s (grid %d)\n", hipGetErrorString(e), grid);
#else
    for (int ph = 0; ph < NPH; ++ph) {
        if (ph == 4 || ph == 19) continue;
        a.ph_lo = ph; a.ph_hi = ph + 1;
        hipLaunchKernelGGL(mk_fwd, dim3(grid), dim3(NWAVES * 64), LDS_BYTES, stream, a);
    }
#endif
}
```

```cpp
#include <hip/hip_runtime.h>
#include <hip/hip_cooperative_groups.h>
#include <cstdio>
#include <cstdint>
#define MK_SINGLE 1
namespace pg8 {
#define PG8_LAS __attribute__((address_space(3)))
typedef unsigned short bf16_t;
typedef short bf16x8 __attribute__((ext_vector_type(8)));
typedef float f32x4 __attribute__((ext_vector_type(4)));
typedef unsigned u32x4 __attribute__((ext_vector_type(4)));
constexpr int BM = 256, BK = 64, HALF = 128, HTB = HALF * BK * 2  , STAGE_BYTES = 8 * HTB, NXCD = 8, WGM = 8;

__host__ __device__ __forceinline__ int lds_byte(int r, int c) { const int st = (r >> 4) * 2 + (c >> 5), rr = r & 15, cc = c & 31, ob = rr * 64 + cc * 2; return st * 1024 + (ob ^ (((ob >> 9) & 1) << 5)); }
__host__ __device__ __forceinline__ void stage_rc(int b, int& R, int& C) { const int st = b / 1024, sb = b % 1024, swz = sb ^ (((sb >> 9) & 1) << 5); R = (st >> 1) * 16 + swz / 64; C = (st & 1) * 32 + (swz % 64) / 2; }
__host__ __device__ __forceinline__ int perm32(int rho) { const int n = rho >> 4, i = rho & 15; return 8 * (i >> 2) + 4 * n + (i & 3); }

struct Unit { int pm, pn, ko; };
struct Gemm { const bf16_t* A; const bf16_t* Bt; int M, N, K; int ld = 0; };

struct StaticOrder {
    int nM, nN, nwg, G, c;
    __host__ __device__ void init(int M, int N, int G_, int c_) { nM = M / BM; nN = N / BM; nwg = nM * nN; G = G_; c = c_; }
    __host__ __device__ bool next(int i, Unit& u) const {
        const long L = (long)i * G + c; if (L >= nwg) return false;
        int wgid = (int)L; { const int q = nwg / NXCD, r = nwg % NXCD, xcd = wgid % NXCD, off = wgid / NXCD; wgid = (xcd < r ? xcd * (q + 1) : r * (q + 1) + (xcd - r) * q) + off; }
        const int nig = WGM * nN, gid = wgid / nig, fm = gid * WGM, gsz = (nM - fm) < WGM ? (nM - fm) : WGM;
        u.pm = fm + ((wgid % nig) % gsz); u.pn = (wgid % nig) / gsz; u.ko = 0; return true;
    }
    __device__ __forceinline__ void a_ready(const Unit&) const {}
    __device__ __forceinline__ void done(const Unit&) const {}
};
struct SplitOrder {
    int c, G;
    __host__ __device__ bool next(int i, Unit& u) const { const int L = i * G + c; if (L >= 256) return false; u.pm = 64 + (L >> 6); u.pn = (L >> 3) & 7; u.ko = (L & 7) * 512; return true; }
    __device__ __forceinline__ void a_ready(const Unit&) const {}
    __device__ __forceinline__ void done(const Unit&) const {}
};
__device__ __forceinline__ unsigned cvt_pk_bf16(float lo, float hi) { unsigned r; asm volatile("v_cvt_pk_bf16_f32 %0, %1, %2" : "=v"(r) : "v"(lo), "v"(hi)); return r; }
typedef float f32x2 __attribute__((ext_vector_type(2)));
typedef unsigned u32x2 __attribute__((ext_vector_type(2)));
#define PG8_GAS __attribute__((address_space(1)))
__device__ __forceinline__ float silu_f(float z) { return z * __builtin_amdgcn_rcpf(1.0f + __builtin_amdgcn_exp2f(-1.4426950408889634f * z)); }

template <int KIND, long SLOT, long MROWS> struct EpiSplit {
    static constexpr bool PERM = false, AFTER_DRAIN = false;
    bf16_t* base;
    __device__ __forceinline__ void operator()(const f32x4 (&acc)[2][2][4][2], const Unit& u, int wr, int wc, int fr, int fq) const {
        const int pn = u.pn; long boff; int ld, tt;
        if (KIND == 1) { const int s = pn >> 4; boff = (long)s * SLOT; ld = 4096; tt = s << 4; }
        else { if (pn < 16) { boff = 0; ld = 4096; tt = 0; } else if (pn < 20) { boff = SLOT; ld = 1024; tt = 16; } else if (pn < 24) { boff = SLOT + MROWS * 1024; ld = 1024; tt = 20; } else { boff = 3 * SLOT; ld = 4096; tt = 24; } }
        const int row0 = u.pm * BM + wr * 64 + fr, col0 = (pn - tt) * BM + wc * 32 + 8 * fq;
        bf16_t* B = base + boff + (size_t)row0 * ld + col0;
#pragma unroll
        for (int ai = 0; ai < 2; ++ai)
#pragma unroll
            for (int m = 0; m < 4; ++m) { bf16_t* rowp = B + (size_t)((ai * HALF + m * 16) * ld);
#pragma unroll
                for (int bj = 0; bj < 2; ++bj) { const f32x4 v0 = acc[ai][bj][m][0], v1 = acc[ai][bj][m][1];
                    u32x4 w; w.x = cvt_pk_bf16(v0[0], v0[1]); w.y = cvt_pk_bf16(v0[2], v0[3]); w.z = cvt_pk_bf16(v1[0], v1[1]); w.w = cvt_pk_bf16(v1[2], v1[3]);
                    *(PG8_GAS u32x4*)(rowp + bj * HALF) = w; } }
    }
};
template <long SLOT> struct EpiDiff {
    static constexpr bool PERM = false, AFTER_DRAIN = false;
    bf16_t* base; const float* qn; const float* kn; const float* tab; float qscale;
    __device__ __forceinline__ void operator()(const f32x4 (&acc)[2][2][4][2], const Unit& u, int wr, int wc, int fr, int fq) const {
        const int pn = u.pn;
        if (pn >= 32) {
            const int s = pn >> 4; const int row0 = u.pm * BM + wr * 64 + fr, col0 = (pn - (s << 4)) * BM + wc * 32 + 8 * fq;
            bf16_t* B = base + (long)s * SLOT + (size_t)row0 * 4096 + col0;
#pragma unroll
            for (int ai = 0; ai < 2; ++ai)
#pragma unroll
                for (int m = 0; m < 4; ++m) { bf16_t* rowp = B + (size_t)((ai * HALF + m * 16) * 4096);
#pragma unroll
                    for (int bj = 0; bj < 2; ++bj) { const f32x4 v0 = acc[ai][bj][m][0], v1 = acc[ai][bj][m][1];
                        u32x4 w; w.x = cvt_pk_bf16(v0[0], v0[1]); w.y = cvt_pk_bf16(v0[2], v0[3]); w.z = cvt_pk_bf16(v1[0], v1[1]); w.w = cvt_pk_bf16(v1[2], v1[3]);
                        *(PG8_GAS u32x4*)(rowp + bj * HALF) = w; } }
            return;
        }
        const bool isq = pn < 16, latent = u.pm < 64;
        const float* gain = isq ? qn : kn; const float osc = isq ? qscale : 1.0f;
        f32x4 gg[2][2];
#pragma unroll
        for (int bj = 0; bj < 2; ++bj)
#pragma unroll
            for (int n = 0; n < 2; ++n) gg[bj][n] = *(const PG8_GAS f32x4*)(gain + 32 * bj + 16 * n + 4 * fq);
        bf16_t* B = base + (isq ? 0 : SLOT) + (size_t)(u.pm * BM + wr * 64 + fr) * 4096 + (pn & 15) * BM + 64 * wc + 16 * fq;
#pragma unroll
        for (int ai = 0; ai < 2; ++ai) {
            const int prow = (4 * u.pm + 2 * ai + wr) & 63;
            const f32x4 ra = *(const PG8_GAS f32x4*)(tab + (prow * 16 + 4 * fq) * 2), rb = *(const PG8_GAS f32x4*)(tab + (prow * 16 + 4 * fq) * 2 + 4);
#pragma unroll
            for (int m = 0; m < 4; ++m) {
                const int pcol = 16 * m + fr;
                const f32x4 ca = *(const PG8_GAS f32x4*)(tab + (pcol * 16 + 4 * fq) * 2), cb = *(const PG8_GAS f32x4*)(tab + (pcol * 16 + 4 * fq) * 2 + 4);
                f32x4 y[2][2]; float ss = 0.f;
#pragma unroll
                for (int bj = 0; bj < 2; ++bj)
#pragma unroll
                    for (int n = 0; n < 2; ++n) { y[bj][n] = acc[ai][bj][m][n]; ss += (y[bj][n][0] * y[bj][n][0] + y[bj][n][1] * y[bj][n][1]) + (y[bj][n][2] * y[bj][n][2] + y[bj][n][3] * y[bj][n][3]); }
                ss += __shfl_xor(ss, 16); ss += __shfl_xor(ss, 32);
                const float rstd = 1.0f / sqrtf(ss * (1.0f / 64.0f) + 1e-6f);
#pragma unroll
                for (int bj = 0; bj < 2; ++bj)
#pragma unroll
                    for (int n = 0; n < 2; ++n) y[bj][n] = y[bj][n] * rstd * gg[bj][n];
                if (latent) {
#pragma unroll
                    for (int bj = 0; bj < 2; ++bj) { const f32x4 A = bj == 0 ? ra : ca, Bv = bj == 0 ? rb : cb;
                        const f32x4 c = {A[0], A[2], Bv[0], Bv[2]}, sn = {A[1], A[3], Bv[1], Bv[3]};
                        const f32x4 t1 = y[bj][0], t2 = y[bj][1]; y[bj][0] = t1 * c - t2 * sn; y[bj][1] = t1 * sn + t2 * c; }
                }
                bf16_t* rowp = B + (size_t)((ai * HALF + m * 16) * 4096);
#pragma unroll
                for (int bj = 0; bj < 2; ++bj) { const f32x4 v0 = y[bj][0] * osc, v1 = y[bj][1] * osc;
                    u32x4 w; w.x = cvt_pk_bf16(v0[0], v0[1]); w.y = cvt_pk_bf16(v0[2], v0[3]); w.z = cvt_pk_bf16(v1[0], v1[1]); w.w = cvt_pk_bf16(v1[2], v1[3]);
                    *(PG8_GAS u32x4*)(rowp + 8 * bj) = w; }
            }
        }
    }
};
template <long SLOT, long MROWS> struct EpiWin {
    static constexpr bool PERM = false, AFTER_DRAIN = false;
    bf16_t* base; const float* qn; const float* kn; const float* tab; float qscale; PG8_LAS float* xch;
    __device__ __forceinline__ void operator()(const f32x4 (&acc)[2][2][4][2], const Unit& u, int wr, int wc, int fr, int fq) const {
        const int pn = u.pn;
        if (pn >= 20) {
            long boff; int ld, tt; if (pn < 24) { boff = SLOT + MROWS * 1024; ld = 1024; tt = 20; } else { boff = 3 * SLOT; ld = 4096; tt = 24; }
            const int row0 = u.pm * BM + wr * 64 + fr, col0 = (pn - tt) * BM + wc * 32 + 8 * fq;
            bf16_t* B = base + boff + (size_t)row0 * ld + col0;
#pragma unroll
            for (int ai = 0; ai < 2; ++ai)
#pragma unroll
                for (int m = 0; m < 4; ++m) { bf16_t* rowp = B + (size_t)((ai * HALF + m * 16) * ld);
#pragma unroll
                    for (int bj = 0; bj < 2; ++bj) { const f32x4 v0 = acc[ai][bj][m][0], v1 = acc[ai][bj][m][1];
                        u32x4 w; w.x = cvt_pk_bf16(v0[0], v0[1]); w.y = cvt_pk_bf16(v0[2], v0[3]); w.z = cvt_pk_bf16(v1[0], v1[1]); w.w = cvt_pk_bf16(v1[2], v1[3]);
                        *(PG8_GAS u32x4*)(rowp + bj * HALF) = w; } }
            return;
        }
        const bool isq = pn < 16, latent = u.pm < 64; const int w1 = wc & 1;
        const float* gain = isq ? qn : kn; const float osc = isq ? qscale : 1.0f;
        f32x4 gg[2][2];
#pragma unroll
        for (int bj = 0; bj < 2; ++bj)
#pragma unroll
            for (int n = 0; n < 2; ++n) gg[bj][n] = *(const PG8_GAS f32x4*)(gain + 64 * w1 + 32 * bj + 16 * n + 4 * fq);
        float ps[2][4];
#pragma unroll
        for (int ai = 0; ai < 2; ++ai)
#pragma unroll
            for (int m = 0; m < 4; ++m) { float ss = 0.f;
#pragma unroll
                for (int bj = 0; bj < 2; ++bj)
#pragma unroll
                    for (int n = 0; n < 2; ++n) { const f32x4 v = acc[ai][bj][m][n]; ss += (v[0] * v[0] + v[1] * v[1]) + (v[2] * v[2] + v[3] * v[3]); }
                ss += __shfl_xor(ss, 16); ss += __shfl_xor(ss, 32); ps[ai][m] = ss;
                if (fq == 0) xch[(ai * HALF + wr * 64 + m * 16 + fr) * 4 + wc] = ss; }
        asm volatile("s_waitcnt lgkmcnt(0)" ::: "memory"); __builtin_amdgcn_s_barrier(); asm volatile("" ::: "memory");
#pragma unroll
        for (int ai = 0; ai < 2; ++ai)
#pragma unroll
            for (int m = 0; m < 4; ++m) ps[ai][m] += xch[(ai * HALF + wr * 64 + m * 16 + fr) * 4 + (wc ^ 1)];
        const int ldo = isq ? 4096 : 1024;
        bf16_t* B = base + (isq ? (long)pn * BM : SLOT + (long)(pn - 16) * BM) + (size_t)(u.pm * BM + wr * 64 + fr) * ldo + 64 * wc + 16 * fq;
#pragma unroll
        for (int ai = 0; ai < 2; ++ai) {
            const int prow = (4 * u.pm + 2 * ai + wr) & 63;
#pragma unroll
            for (int m = 0; m < 4; ++m) {
                const int pos = w1 ? (16 * m + fr) : prow;
                const float rstd = 1.0f / sqrtf(ps[ai][m] * (1.0f / 128.0f) + 1e-6f);
                f32x4 y[2][2];
#pragma unroll
                for (int bj = 0; bj < 2; ++bj)
#pragma unroll
                    for (int n = 0; n < 2; ++n) y[bj][n] = acc[ai][bj][m][n] * rstd * gg[bj][n];
                if (latent) {
#pragma unroll
                    for (int n = 0; n < 2; ++n) { const float* tp = tab + (pos * 32 + 16 * n + 4 * fq) * 2;
                        const f32x4 A = *(const PG8_GAS f32x4*)tp, Bv = *(const PG8_GAS f32x4*)(tp + 4);
                        const f32x4 c = {A[0], A[2], Bv[0], Bv[2]}, sn = {A[1], A[3], Bv[1], Bv[3]};
                        const f32x4 t1 = y[0][n], t2 = y[1][n]; y[0][n] = t1 * c - t2 * sn; y[1][n] = t1 * sn + t2 * c; }
                }
                bf16_t* rowp = B + (size_t)((ai * HALF + m * 16) * ldo);
#pragma unroll
                for (int bj = 0; bj < 2; ++bj) { const f32x4 v0 = y[bj][0] * osc, v1 = y[bj][1] * osc;
                    u32x4 w; w.x = cvt_pk_bf16(v0[0], v0[1]); w.y = cvt_pk_bf16(v0[2], v0[3]); w.z = cvt_pk_bf16(v1[0], v1[1]); w.w = cvt_pk_bf16(v1[2], v1[3]);
                    *(PG8_GAS u32x4*)(rowp + 8 * bj) = w; }
            }
        }
    }
};
struct EpiConv {
    static constexpr bool PERM = false, AFTER_DRAIN = false;
    bf16_t* U; bf16_t* BZ;
    __device__ __forceinline__ void operator()(const f32x4 (&acc)[2][2][4][2], const Unit& u, int wr, int wc, int fr, int fq) const {
        const int row0 = u.pm * BM + wr * 64 + fr, col0 = u.pn * 64 + wc * 16 + 4 * fq;
#pragma unroll
        for (int ai = 0; ai < 2; ++ai)
#pragma unroll
            for (int m = 0; m < 4; ++m) { const size_t off = (size_t)(row0 + ai * HALF + m * 16) * 4096 + col0;
                const f32x4 bg = acc[ai][0][m][0], cg = acc[ai][0][m][1], xt = acc[ai][1][m][0], z = acc[ai][1][m][1];
                const f32x4 uu = cg * xt; f32x4 bz; bz[0] = bg[0] * silu_f(z[0]); bz[1] = bg[1] * silu_f(z[1]); bz[2] = bg[2] * silu_f(z[2]); bz[3] = bg[3] * silu_f(z[3]);
                u32x2 a; a.x = cvt_pk_bf16(uu[0], uu[1]); a.y = cvt_pk_bf16(uu[2], uu[3]); *(PG8_GAS u32x2*)(U + off) = a;
                u32x2 b; b.x = cvt_pk_bf16(bz[0], bz[1]); b.y = cvt_pk_bf16(bz[2], bz[3]); *(PG8_GAS u32x2*)(BZ + off) = b; }
    }
};
struct EpiConvF {
    static constexpr bool PERM = false, AFTER_DRAIN = false;
    bf16_t* G; float* H; const float* cw; const float* cb; PG8_LAS float* xch; int ntiles;
    __device__ __forceinline__ void operator()(const f32x4 (&acc)[2][2][4][2], const Unit& u, int wr, int wc, int fr, int fq) const {
        const int col0 = u.pn * 64 + wc * 16 + 4 * fq, lane = fr + 16 * fq;
        const f32x4 w0 = *(const PG8_GAS f32x4*)(cw + col0), w1 = *(const PG8_GAS f32x4*)(cw + 4096 + col0), w2 = *(const PG8_GAS f32x4*)(cw + 8192 + col0), bb = *(const PG8_GAS f32x4*)(cb + col0);
        f32x4 uu[2][4], bzv[2][4];
#pragma unroll
        for (int ai = 0; ai < 2; ++ai)
#pragma unroll
            for (int m = 0; m < 4; ++m) { const f32x4 bg = acc[ai][0][m][0], cg = acc[ai][0][m][1], xt = acc[ai][1][m][0], z = acc[ai][1][m][1];
                uu[ai][m] = cg * xt; f32x4 b; b[0] = bg[0] * silu_f(z[0]); b[1] = bg[1] * silu_f(z[1]); b[2] = bg[2] * silu_f(z[2]); b[3] = bg[3] * silu_f(z[3]); bzv[ai][m] = b; }
        PG8_LAS float* xw = xch + wc * 16 + 4 * fq;
#pragma unroll
        for (int ai = 0; ai < 2; ++ai) { const int b = 2 * ai + wr;
            if (fr == 0) *(PG8_LAS f32x4*)(xw + (b * 2 + 0) * 64) = uu[ai][0];
            if (fr == 15) *(PG8_LAS f32x4*)(xw + (b * 2 + 1) * 64) = uu[ai][3]; }
        asm volatile("s_waitcnt lgkmcnt(0)" ::: "memory"); __builtin_amdgcn_s_barrier(); asm volatile("" ::: "memory");
        const int upl = (lane & 48) | ((fr + 15) & 15), dnl = (lane & 48) | ((fr + 1) & 15);
        const f32x4 zero4 = {0.f, 0.f, 0.f, 0.f};
#pragma unroll
        for (int ai = 0; ai < 2; ++ai) { const int b = 2 * ai + wr;
            const f32x4 prevX = b > 0 ? *(const PG8_LAS f32x4*)(xw + ((b - 1) * 2 + 1) * 64) : zero4;
            const f32x4 nextX = b < 3 ? *(const PG8_LAS f32x4*)(xw + ((b + 1) * 2 + 0) * 64) : zero4;
#pragma unroll
            for (int m = 0; m < 4; ++m) {
                const f32x4 su = (m > 0 && fr == 15) ? uu[ai][m > 0 ? m - 1 : 0] : uu[ai][m];
                const f32x4 sd = (m < 3 && fr == 0) ? uu[ai][m < 3 ? m + 1 : 3] : uu[ai][m];
                f32x4 up, dn;
#pragma unroll
                for (int e = 0; e < 4; ++e) { up[e] = __shfl(su[e], upl); dn[e] = __shfl(sd[e], dnl); }
                if (m == 0 && fr == 0) up = prevX;
                if (m == 3 && fr == 15) dn = nextX;
                const f32x4 mid = w1 * uu[ai][m] + bb, y = w0 * up + mid + w2 * dn, g = bzv[ai][m] * y;
                const size_t row = (size_t)u.pm * BM + ai * HALF + wr * 64 + m * 16 + fr;
                u32x2 o; o.x = cvt_pk_bf16(g[0], g[1]); o.y = cvt_pk_bf16(g[2], g[3]); *(PG8_GAS u32x2*)(G + row * 4096 + col0) = o;
                if (b == 0 && m == 0 && fr == 0) { float* h = H + ((size_t)u.pm * 2 + 0) * 4096 + col0; const size_t hs = (size_t)ntiles * 2 * 4096;
                    *(PG8_GAS f32x4*)h = uu[ai][m]; *(PG8_GAS f32x4*)(h + hs) = mid + w2 * dn; *(PG8_GAS f32x4*)(h + 2 * hs) = bzv[ai][m]; }
                if (b == 3 && m == 3 && fr == 15) { float* h = H + ((size_t)u.pm * 2 + 1) * 4096 + col0; const size_t hs = (size_t)ntiles * 2 * 4096;
                    *(PG8_GAS f32x4*)h = uu[ai][m]; *(PG8_GAS f32x4*)(h + hs) = w0 * up + mid; *(PG8_GAS f32x4*)(h + 2 * hs) = bzv[ai][m]; }
            }
        }
    }
};
struct EpiResid {
    static constexpr bool PERM = false, AFTER_DRAIN = false;
    const float* xin; float* xout; const float* mod;
    __device__ __forceinline__ void operator()(const f32x4 (&acc)[2][2][4][2], const Unit& u, int wr, int wc, int fr, int fq) const {
        const float* src = xin + (size_t)u.pm * BM * 2048; float* dst = xout + (size_t)u.pm * BM * 2048;
        const float* gate = mod + (u.pm >> 4) * 6144 + 4096;
        const int rl = wr * 64 + fr, col0 = u.pn * BM + wc * 32 + 4 * fq;
        f32x4 gv[2][2];
#pragma unroll
        for (int bj = 0; bj < 2; ++bj)
#pragma unroll
            for (int n = 0; n < 2; ++n) gv[bj][n] = *(const PG8_GAS f32x4*)(gate + col0 + bj * HALF + n * 16);
#pragma unroll
        for (int ai = 0; ai < 2; ++ai)
#pragma unroll
            for (int mp = 0; mp < 2; ++mp) { f32x4 xs[2][2][2];
#pragma unroll
                for (int mm = 0; mm < 2; ++mm) { const size_t off = (size_t)(rl + ai * HALF + (2 * mp + mm) * 16) * 2048 + col0;
#pragma unroll
                    for (int bj = 0; bj < 2; ++bj)
#pragma unroll
                        for (int n = 0; n < 2; ++n) xs[mm][bj][n] = *(const PG8_GAS f32x4*)(src + off + bj * HALF + n * 16); }
#pragma unroll
                for (int mm = 0; mm < 2; ++mm) { const size_t off = (size_t)(rl + ai * HALF + (2 * mp + mm) * 16) * 2048 + col0;
#pragma unroll
                    for (int bj = 0; bj < 2; ++bj)
#pragma unroll
                        for (int n = 0; n < 2; ++n) *(PG8_GAS f32x4*)(dst + off + bj * HALF + n * 16) = xs[mm][bj][n] + gv[bj][n] * acc[ai][bj][2 * mp + mm][n]; }
                asm volatile("" ::: "memory"); }
    }
};
struct EpiSlab {
    static constexpr bool PERM = false, AFTER_DRAIN = false;
    float* slab;
    __device__ __forceinline__ void operator()(const f32x4 (&acc)[2][2][4][2], const Unit& u, int wr, int wc, int fr, int fq) const {
        float* dst = slab + ((size_t)(u.ko >> 9) * 1024 + (size_t)(u.pm - 64) * BM) * 2048;
        const int rl = wr * 64 + fr, col0 = u.pn * BM + wc * 32 + 4 * fq;
#pragma unroll
        for (int ai = 0; ai < 2; ++ai)
#pragma unroll
            for (int m = 0; m < 4; ++m) { const size_t off = (size_t)(rl + ai * HALF + m * 16) * 2048 + col0;
#pragma unroll
                for (int bj = 0; bj < 2; ++bj)
#pragma unroll
                    for (int n = 0; n < 2; ++n) *(PG8_GAS f32x4*)(dst + off + bj * HALF + n * 16) = acc[ai][bj][m][n]; }
    }
};
template <class Epi, class Sched, bool ALIGN_EPI = false, bool SP2 = false>
__device__ __forceinline__ void gemm_phase(PG8_LAS unsigned char* lds, const Gemm g, const Sched& S, const Epi& E) {
    int tid_ = threadIdx.x; asm volatile("" : "+v"(tid_));
    const int tid = tid_, wid = __builtin_amdgcn_readfirstlane(tid >> 6), lane = tid & 63, wr = wid >> 2, wc = wid & 3, fr = lane & 15, fq = lane >> 4;
    const int K = g.K, nt = K / BK, LD = g.ld ? g.ld : g.K;
    unsigned voffA[2], voffB[2];
#pragma unroll
    for (int i = 0; i < 2; ++i) { int R, C; stage_rc(tid * 16 + i * 8192, R, C); const int Rb = Epi::PERM ? ((R & ~31) + perm32(R & 31)) : R;
        voffA[i] = (unsigned)(R * LD + C) * 2u; voffB[i] = (unsigned)(Rb * LD + C) * 2u; }
    const size_t kstep = (size_t)(BK * 2);
    const size_t hstep = (size_t)HALF * LD * 2;
    const size_t tstep = 2 * hstep;
    const unsigned ldsw = (unsigned)wid * 1024u;
    const int aoff = lds_byte(wr * 64 + fr, fq * 8), boff = lds_byte(wc * 32 + fr, fq * 8);
#define PG8_SA(b, h) (((b) * 2 + (h)) * HTB)
#define PG8_SB(b, h) ((4 + (b) * 2 + (h)) * HTB)
#define PG8_STAGE(bufoff, gbase, voff) do { _Pragma("unroll") for (int _i = 0; _i < 2; ++_i) \
        __builtin_amdgcn_global_load_lds((const unsigned*)((const char*)(gbase) + (voff)[_i]), (PG8_LAS unsigned*)(lds + (bufoff) + ldsw + _i * 8192), 16, 0, 0); } while (0)
#define PG8_LDA(dst, b, h) do { _Pragma("unroll") for (int m = 0; m < 4; ++m) _Pragma("unroll") for (int k = 0; k < 2; ++k) dst[m][k] = *(const PG8_LAS bf16x8*)(lds + PG8_SA(b, h) + aoff + m * 2048 + k * 1024); } while (0)
#define PG8_LDB(dst, b, h) do { _Pragma("unroll") for (int n = 0; n < 2; ++n) _Pragma("unroll") for (int k = 0; k < 2; ++k) dst[n][k] = *(const PG8_LAS bf16x8*)(lds + PG8_SB(b, h) + boff + n * 2048 + k * 1024); } while (0)
#define PG8_MMA(ai, bj, At, Bt) do { __builtin_amdgcn_s_setprio(1); _Pragma("unroll") for (int m = 0; m < 4; ++m) _Pragma("unroll") for (int n = 0; n < 2; ++n) _Pragma("unroll") for (int k = 0; k < 2; ++k) \
        acc[ai][bj][m][n] = __builtin_amdgcn_mfma_f32_16x16x32_bf16(Bt[n][k], At[m][k], acc[ai][bj][m][n], 0, 0, 0); __builtin_amdgcn_s_setprio(0); } while (0)
#define PG8_WAIT_V(n) asm volatile("s_waitcnt vmcnt(" #n ")" ::: "memory")
#define PG8_WAIT_L(n) asm volatile("s_waitcnt lgkmcnt(" #n ")" ::: "memory")
#define PG8_BAR __builtin_amdgcn_s_barrier()
#define PG8_SCHED __builtin_amdgcn_sched_barrier(0)
    Unit cur, nxt; int ui = 0;
    if (!S.next(0, cur)) return;
    f32x4 acc[2][2][4][2];
#pragma unroll
    for (int a = 0; a < 2; ++a)
#pragma unroll
        for (int b = 0; b < 2; ++b)
#pragma unroll
            for (int m = 0; m < 4; ++m)
#pragma unroll
                for (int n = 0; n < 2; ++n) acc[a][b][m][n] = (f32x4){0.f, 0.f, 0.f, 0.f};
    bf16x8 At[4][2], B0[2][2], B1[2][2];
    const char* cA = (const char*)g.A + (size_t)cur.pm * tstep + (size_t)cur.ko * 2; const char* cB = (const char*)g.Bt + (size_t)cur.pn * tstep + (size_t)cur.ko * 2;
    S.a_ready(cur);
    if constexpr (SP2) {
        PG8_STAGE(PG8_SB(0, 0), cB, voffB); PG8_STAGE(PG8_SB(0, 1), cB + hstep, voffB); PG8_STAGE(PG8_SA(0, 0), cA, voffA); PG8_STAGE(PG8_SA(0, 1), cA + hstep, voffA);
        if (wr == 1) PG8_BAR;
        PG8_WAIT_V(2); PG8_BAR;
        PG8_STAGE(PG8_SB(1, 0), cB + kstep, voffB); PG8_STAGE(PG8_SA(1, 0), cA + kstep, voffA); PG8_STAGE(PG8_SB(1, 1), cB + hstep + kstep, voffB);
        PG8_WAIT_V(6); PG8_BAR;
    } else {
        PG8_STAGE(PG8_SB(0, 0), cB, voffB); PG8_STAGE(PG8_SA(0, 0), cA, voffA); PG8_STAGE(PG8_SB(0, 1), cB + hstep, voffB); PG8_STAGE(PG8_SA(0, 1), cA + hstep, voffA);
        if (wr == 1) PG8_BAR;
        PG8_WAIT_V(4); PG8_BAR;
        PG8_STAGE(PG8_SB(1, 0), cB + kstep, voffB); PG8_STAGE(PG8_SA(1, 0), cA + kstep, voffA); PG8_STAGE(PG8_SB(1, 1), cB + hstep + kstep, voffB);
        PG8_WAIT_V(6); PG8_BAR;
    }
    for (;;) {
        const bool has_next = S.next(ui + 1, nxt);
        const char* nA = has_next ? (const char*)g.A + (size_t)nxt.pm * tstep + (size_t)nxt.ko * 2 : cA; const char* nB = has_next ? (const char*)g.Bt + (size_t)nxt.pn * tstep + (size_t)nxt.ko * 2 : cB;
        for (int t = 0; t < nt; t += 2) {
            const bool last = (t == nt - 2);
            const char* a1 = cA + (size_t)(t + 1) * kstep;
            const char* a2 = last ? nA : cA + (size_t)(t + 2) * kstep; const char* b2 = last ? nB : cB + (size_t)(t + 2) * kstep;
            const char* a3 = a2 + kstep; const char* b3 = b2 + kstep;
            if (last && has_next) S.a_ready(nxt);
            if constexpr (SP2) {
            PG8_LDB(B0, 0, 0); PG8_LDB(B1, 0, 1); PG8_SCHED; PG8_LDA(At, 0, 0); PG8_STAGE(PG8_SA(1, 1), a1 + hstep, voffA);
            PG8_WAIT_V(8); PG8_WAIT_L(0); PG8_BAR; PG8_MMA(0, 0, At, B0); PG8_MMA(0, 1, At, B1); PG8_BAR; PG8_SCHED;
            PG8_LDA(At, 0, 1); PG8_STAGE(PG8_SB(0, 0), b2, voffB); PG8_STAGE(PG8_SB(0, 1), b2 + hstep, voffB); PG8_STAGE(PG8_SA(0, 0), a2, voffA);
            PG8_WAIT_V(8); PG8_WAIT_L(0); PG8_BAR; PG8_MMA(1, 0, At, B0); PG8_MMA(1, 1, At, B1); PG8_BAR; PG8_SCHED;
            PG8_LDB(B0, 1, 0); PG8_LDB(B1, 1, 1); PG8_SCHED; PG8_LDA(At, 1, 0); PG8_STAGE(PG8_SA(0, 1), a2 + hstep, voffA);
            PG8_WAIT_V(8); PG8_WAIT_L(0); PG8_BAR; PG8_MMA(0, 0, At, B0); PG8_MMA(0, 1, At, B1); PG8_BAR; PG8_SCHED;
            PG8_LDA(At, 1, 1); PG8_STAGE(PG8_SB(1, 0), b3, voffB); PG8_STAGE(PG8_SB(1, 1), b3 + hstep, voffB); PG8_STAGE(PG8_SA(1, 0), a3, voffA);
            PG8_WAIT_V(8); PG8_WAIT_L(0); PG8_BAR; PG8_MMA(1, 0, At, B0); PG8_MMA(1, 1, At, B1); PG8_BAR; PG8_SCHED;
            } else {
            PG8_LDB(B0, 0, 0); PG8_SCHED; PG8_LDA(At, 0, 0); PG8_STAGE(PG8_SA(1, 1), a1 + hstep, voffA);
            PG8_WAIT_L(8); PG8_BAR; PG8_WAIT_L(0); PG8_MMA(0, 0, At, B0); PG8_BAR; PG8_SCHED;
            PG8_LDB(B1, 0, 1); PG8_STAGE(PG8_SB(0, 0), b2, voffB);
            PG8_BAR; PG8_WAIT_L(0); PG8_MMA(0, 1, At, B1); PG8_BAR;
            PG8_LDA(At, 0, 1); PG8_STAGE(PG8_SA(0, 0), a2, voffA);
            PG8_BAR; PG8_WAIT_L(0); PG8_MMA(1, 0, At, B0); PG8_BAR; PG8_SCHED;
            PG8_STAGE(PG8_SB(0, 1), b2 + hstep, voffB);
            PG8_WAIT_V(6); PG8_BAR; PG8_MMA(1, 1, At, B1); PG8_BAR;
            PG8_LDB(B0, 1, 0); PG8_SCHED; PG8_LDA(At, 1, 0); PG8_STAGE(PG8_SA(0, 1), a2 + hstep, voffA);
            PG8_WAIT_L(8); PG8_BAR; PG8_WAIT_L(0); PG8_MMA(0, 0, At, B0); PG8_BAR; PG8_SCHED;
            PG8_LDB(B1, 1, 1); PG8_STAGE(PG8_SB(1, 0), b3, voffB);
            PG8_BAR; PG8_WAIT_L(0); PG8_MMA(0, 1, At, B1); PG8_BAR;
            PG8_LDA(At, 1, 1); PG8_STAGE(PG8_SA(1, 0), a3, voffA);
            PG8_BAR; PG8_WAIT_L(0); PG8_MMA(1, 0, At, B0); PG8_BAR; PG8_SCHED;
            PG8_STAGE(PG8_SB(1, 1), b3 + hstep, voffB);
            PG8_WAIT_V(6); PG8_BAR; PG8_MMA(1, 1, At, B1); PG8_BAR;
            }
        }
        if constexpr (ALIGN_EPI) { if (wr == 0) PG8_BAR; }
        if constexpr (!Epi::AFTER_DRAIN) { E(acc, cur, wr, wc, fr, fq); S.done(cur); }
        if (!has_next) break;
#pragma unroll
        for (int a = 0; a < 2; ++a)
#pragma unroll
            for (int b = 0; b < 2; ++b)
#pragma unroll
                for (int m = 0; m < 4; ++m)
#pragma unroll
                    for (int n = 0; n < 2; ++n) acc[a][b][m][n] = (f32x4){0.f, 0.f, 0.f, 0.f};
        cur = nxt; cA = nA; cB = nB; ++ui;
        if constexpr (ALIGN_EPI) { if (wr == 1) PG8_BAR; }
    }
    PG8_WAIT_V(0);
    if constexpr (!ALIGN_EPI) { if (wr == 0) PG8_BAR; }
    PG8_BAR;
    if constexpr (Epi::AFTER_DRAIN) { E.fused(acc, cur, wr, wc, fr, fq, lds, wid, lane); S.done(cur); }
#undef PG8_SA
#undef PG8_SB
#undef PG8_STAGE
#undef PG8_LDA
#undef PG8_LDB
#undef PG8_MMA
#undef PG8_WAIT_V
#undef PG8_WAIT_L
#undef PG8_BAR
#undef PG8_SCHED
}
}
namespace cg = cooperative_groups;
#define LAS __attribute__((address_space(3)))
#define GAS __attribute__((address_space(1)))
typedef unsigned short bf16;
typedef unsigned v4u __attribute__((ext_vector_type(4)));
typedef unsigned v2u __attribute__((ext_vector_type(2)));
typedef float f32x4 __attribute__((ext_vector_type(4)));
typedef float f32x16 __attribute__((ext_vector_type(16)));
typedef short bf16x8 __attribute__((ext_vector_type(8)));
typedef short s16x4 __attribute__((ext_vector_type(4)));
typedef float f32x2_t __attribute__((ext_vector_type(2)));
typedef __bf16 bf16x2_t __attribute__((ext_vector_type(2)));

constexpr int DM = 2048, DI = 4096, SEQ = 4096, ML = 16384, MC = 1024, MT = ML + MC;
constexpr float EPS = 1e-6f, LOG2E = 1.4426950408889634f;
constexpr float LAM_INIT1 = 0.35550906f;
constexpr int NWAVES = 8, NPH = 21;
constexpr int LDS_BYTES = 147456, LDS_BARST = LDS_BYTES - 64;

constexpr size_t MiB = 1u << 20;
constexpr size_t WS_MOD = 0, MOD_ZERO_BYTES = 512 * 1024;
constexpr size_t WS_BAR = 496 * 1024;
constexpr size_t WS_TAB = 1 * MiB;
constexpr size_t WS_WTIN = 2 * MiB, WS_WTOUT = 66 * MiB;
constexpr size_t WS_HA = 82 * MiB;
constexpr size_t WS_CBUF = 150 * MiB;
constexpr size_t WS_SLOT = 160 * MiB, SLOT_BYTES = 136 * MiB;
constexpr size_t WS_SLAB = WS_SLOT + 4 * SLOT_BYTES;
constexpr size_t WS_HALO = WS_SLAB + 64 * MiB;
constexpr size_t WS_END = WS_HALO + 8 * MiB;

__device__ __forceinline__ unsigned f2bf(float f) { unsigned u = __builtin_bit_cast(unsigned, f); return (u + 0x7fffu + ((u >> 16) & 1u)) >> 16; }
__device__ __forceinline__ unsigned pk2(float lo, float hi) { f32x2_t v = {lo, hi}; bf16x2_t b = __builtin_convertvector(v, bf16x2_t); return __builtin_bit_cast(unsigned, b); }
__device__ __forceinline__ float bflo(unsigned w) { return __builtin_bit_cast(float, w << 16); }
__device__ __forceinline__ float bfhi(unsigned w) { return __builtin_bit_cast(float, w & 0xffff0000u); }
__device__ __forceinline__ float wave_sum(float v) {
#pragma unroll
    for (int o = 1; o < 64; o <<= 1) v += __shfl_xor(v, o);
    return v;
}
__device__ __forceinline__ float wave_max(float v) {
#pragma unroll
    for (int o = 1; o < 64; o <<= 1) v = fmaxf(v, __shfl_xor(v, o));
    return v;
}
#define LDS_WAIT() asm volatile("s_waitcnt lgkmcnt(0)" ::: "memory")
__device__ __forceinline__ int crow(int r, int hi) { return (r & 3) + 8 * (r >> 2) + 4 * hi; }

enum { MAP_ID = 0, MAP_P32 = 1, MAP_CONV = 2, MAP_DIFF = 3, MAP_WIN = 4 };
template <int MAP> __device__ __forceinline__ int colmap(int slot) {
    if (MAP == MAP_ID) return slot;
    if (MAP == MAP_P32) return (slot & ~31) + pg8::perm32(slot & 31);
    const int pn = slot >> 8, s = slot & 255, bj = s >> 7, wc = (s >> 5) & 3, n = (s >> 4) & 1, q = s & 15;
    if (MAP == MAP_WIN) return pn < 20 ? pn * 256 + 64 * wc + 32 * bj + 16 * n + q : (slot & ~31) + pg8::perm32(slot & 31);
    if (MAP == MAP_DIFF) return pn < 32 ? pn * 256 + 64 * wc + 32 * bj + 16 * n + q : (slot & ~31) + pg8::perm32(slot & 31);
    return (2 * bj + n) * 4096 + 64 * pn + 16 * wc + q;
}
template <int MAP> __device__ __forceinline__ void transpose_item(const float* W, int K, int N, bf16* WT, LAS float* scr, int item, int lane) {
    const int nblk = N / 32, kb = item / nblk, nb = item % nblk, k0 = 64 * kb, n0 = 32 * nb;
    const int col = colmap<MAP>(n0 + (lane & 31));
    float tv[32];
#pragma unroll
    for (int i = 0; i < 32; ++i) { const int kk = 2 * i + (lane >> 5); tv[i] = ((const GAS float*)W)[(size_t)(k0 + kk) * N + col]; }
#pragma unroll
    for (int i = 0; i < 32; ++i) { const int kk = 2 * i + (lane >> 5); scr[kk * 33 + (lane & 31)] = tv[i]; }
    LDS_WAIT();
    const int c = lane & 7;
#pragma unroll
    for (int j = 0; j < 4; ++j) { const int n = (lane >> 3) + 8 * j; const LAS float* s = scr + (8 * c) * 33 + n;
        v4u o; o.x = pk2(s[0 * 33], s[1 * 33]); o.y = pk2(s[2 * 33], s[3 * 33]); o.z = pk2(s[4 * 33], s[5 * 33]); o.w = pk2(s[6 * 33], s[7 * 33]);
        *(GAS v4u*)(WT + (size_t)(n0 + n) * K + k0 + 8 * c) = o; }
    LDS_WAIT();
}
template <int MAP> __device__ __forceinline__ void transpose_all(const float* W, int K, int N, bf16* WT, LAS float* scr, int gw, int NGW, int lane) {
    const int items = (K / 64) * (N / 32);
    for (int it = gw; it < items; it += NGW) transpose_item<MAP>(W, K, N, WT, scr, it, lane);
}

struct Args { const float* in[38]; float* out; unsigned char* ws; int ph_lo, ph_hi; };
__device__ __forceinline__ const float* argp(int i) { const char* k = (const char*)__builtin_amdgcn_kernarg_segment_ptr(); asm volatile("" : "+s"(k)); const float* p = *(const float* const*)(k + 8 * i); return (const float*)(const GAS float*)p; }

__device__ __forceinline__ void mod_item(float* mod, LAS float* scr, int it, int lane) {
    const int l = it / 1536, r = it % 1536, kc = r / 96, cb = r % 96, k0 = kc * 128, col = cb * 64 + lane;
    const float* Wm = argp(l == 0 ? 5 : l == 1 ? 12 : l == 2 ? 24 : 32);
    const float* bm = argp(l == 0 ? 6 : l == 1 ? 13 : l == 2 ? 25 : 33);
    const float* c = argp(1); const float* cc = argp(3);
#pragma unroll
    for (int j = 0; j < 2; ++j) { const int kk = lane + 64 * j;
#pragma unroll
        for (int bi = 0; bi < 5; ++bi) { const float cv = bi < 4 ? c[bi * 2048 + k0 + kk] : cc[k0 + kk]; scr[bi * 128 + kk] = cv / (1.0f + __expf(-cv)); } }
    LDS_WAIT();
    float acc[5] = {0.f, 0.f, 0.f, 0.f, 0.f};
    const float* wp = Wm + (size_t)k0 * 6144 + col;
#pragma unroll 32
    for (int kk = 0; kk < 128; ++kk) { const float w = ((const GAS float*)wp)[(size_t)kk * 6144];
#pragma unroll
        for (int bi = 0; bi < 5; ++bi) acc[bi] += scr[bi * 128 + kk] * w; }
    if (kc == 0) { const float b = bm[col];
#pragma unroll
        for (int bi = 0; bi < 5; ++bi) acc[bi] += b; }
#pragma unroll
    for (int bi = 0; bi < 5; ++bi) atomicAdd(mod + (size_t)(l * 5 + bi) * 6144 + col, acc[bi]);
    LDS_WAIT();
}

__device__ __forceinline__ void norm_row(const float* src, const float* g, const float* md, bf16* dst, int lane, const float* slab = nullptr, const float* gate = nullptr, float* upd = nullptr) {
    const GAS f32x4* xr = (const GAS f32x4*)src + lane;
    f32x4 v[8]; float s = 0.f;
#pragma unroll
    for (int j = 0; j < 8; ++j) v[j] = xr[64 * j];
    if (slab) {
#pragma unroll
        for (int j = 0; j < 8; ++j) { f32x4 a = {0.f, 0.f, 0.f, 0.f};
#pragma unroll
            for (int ks = 0; ks < 8; ++ks) a += *((const GAS f32x4*)(slab + (size_t)ks * 1024 * 2048) + 64 * j + lane);
            v[j] += a * *((const GAS f32x4*)gate + 64 * j + lane); *((GAS f32x4*)upd + 64 * j + lane) = v[j]; }
    }
#pragma unroll
    for (int j = 0; j < 8; ++j) s += (v[j].x * v[j].x + v[j].y * v[j].y) + (v[j].z * v[j].z + v[j].w * v[j].w);
    const float rstd = 1.0f / sqrtf(wave_sum(s) * (1.0f / 2048.0f) + EPS);
#pragma unroll
    for (int j = 0; j < 8; ++j) { const int col = 256 * j + 4 * lane;
        const f32x4 g4 = *(const GAS f32x4*)(g + col), sh = *(const GAS f32x4*)(md + col), sc = *(const GAS f32x4*)(md + 2048 + col);
        const f32x4 y = (v[j] * rstd) * g4 * (sc + 1.0f) + sh;
        v2u o; o.x = pk2(y.x, y.y); o.y = pk2(y.z, y.w); *(GAS v2u*)(dst + col) = o; }
}

__device__ __forceinline__ void conv_item(const bf16* U, const bf16* BZ, bf16* Gd, const float* cw, const float* cb, int item, int tid) {
    const int r0 = 16 * item, col = 8 * tid;
    int s0, s1; if (r0 < ML) { s0 = r0 & ~4095; s1 = s0 + 4096; } else { s0 = ML + ((r0 - ML) & ~255); s1 = s0 + 256; }
    float w0[8], w1[8], w2[8], bb[8];
#pragma unroll
    for (int h = 0; h < 2; ++h) { const f32x4 a = *(const f32x4*)(cw + col + 4 * h), b = *(const f32x4*)(cw + 4096 + col + 4 * h), c = *(const f32x4*)(cw + 8192 + col + 4 * h), d = *(const f32x4*)(cb + col + 4 * h);
#pragma unroll
        for (int e = 0; e < 4; ++e) { w0[4 * h + e] = a[e]; w1[4 * h + e] = b[e]; w2[4 * h + e] = c[e]; bb[4 * h + e] = d[e]; } }
    const v4u zero = {0u, 0u, 0u, 0u};
    v4u prev = (r0 > s0) ? *(const GAS v4u*)(U + (size_t)(r0 - 1) * 4096 + col) : zero;
    v4u cur = *(const GAS v4u*)(U + (size_t)r0 * 4096 + col);
#pragma unroll 4
    for (int i = 0; i < 16; ++i) { const int r = r0 + i;
        const v4u nxt = (r + 1 < s1) ? *(const GAS v4u*)(U + (size_t)(r + 1) * 4096 + col) : zero;
        const v4u bz = *(const GAS v4u*)(BZ + (size_t)r * 4096 + col);
        v4u o;
#pragma unroll
        for (int w = 0; w < 4; ++w) {
            const float y0 = w0[2 * w] * bflo(prev[w]) + w1[2 * w] * bflo(cur[w]) + w2[2 * w] * bflo(nxt[w]) + bb[2 * w];
            const float y1 = w0[2 * w + 1] * bfhi(prev[w]) + w1[2 * w + 1] * bfhi(cur[w]) + w2[2 * w + 1] * bfhi(nxt[w]) + bb[2 * w + 1];
            o[w] = pk2(bflo(bz[w]) * y0, bfhi(bz[w]) * y1); }
        *(GAS v4u*)(Gd + (size_t)r * 4096 + col) = o;
        prev = cur; cur = nxt; }
}

__device__ __forceinline__ void convfix_item(bf16* Gd, const float* H, const float* cw, int ntiles, int item, int tid) {
    const int pm = item >> 1, sd = item & 1, col = 8 * tid;
    if (pm >= 64) return;
    if (sd == 0 ? (pm & 15) == 0 : (pm & 15) == 15) return;
    const size_t hs = (size_t)ntiles * 2 * 4096;
    const float* h = H + ((size_t)pm * 2 + sd) * 4096 + col;
    const float* hn = H + ((size_t)(sd ? pm + 1 : pm - 1) * 2 + (sd ? 0 : 1)) * 4096 + col;
    const float* w = cw + (sd ? 8192 : 0) + col;
    v4u o;
#pragma unroll
    for (int hh = 0; hh < 2; ++hh) { const f32x4 un = *(const GAS f32x4*)(hn + 4 * hh), yp = *(const GAS f32x4*)(h + hs + 4 * hh), bz = *(const GAS f32x4*)(h + 2 * hs + 4 * hh), ww = *(const GAS f32x4*)(w + 4 * hh);
        const f32x4 g = bz * (yp + ww * un); o[2 * hh] = pk2(g[0], g[1]); o[2 * hh + 1] = pk2(g[2], g[3]); }
    *(GAS v4u*)(Gd + ((size_t)pm * 256 + (sd ? 255 : 0)) * 4096 + col) = o;
}

template <int HD> __device__ __forceinline__ void qknorm_item(bf16* X, int ld, int item, const v4u raw, const float* gain, float oscale, const float2* tab, int lane) {
    constexpr int LPH = HD / 8, NF = HD / 4;
    const int parts = ld / 512, row = item / parts, part = item % parts, col = (part * 64 + lane) * 8, d0 = col % HD;
    bf16* p = X + (size_t)row * ld + col;
    float v[8];
#pragma unroll
    for (int w = 0; w < 4; ++w) { v[2 * w] = bflo(raw[w]); v[2 * w + 1] = bfhi(raw[w]); }
    float ss = 0.f;
#pragma unroll
    for (int e = 0; e < 8; ++e) ss += v[e] * v[e];
#pragma unroll
    for (int o = 1; o < LPH; o <<= 1) ss += __shfl_xor(ss, o);
    const float rstd = 1.0f / sqrtf(ss * (1.0f / HD) + EPS);
#pragma unroll
    for (int e = 0; e < 8; ++e) v[e] = v[e] * rstd * gain[d0 + e];
    float pv[8];
#pragma unroll
    for (int e = 0; e < 8; ++e) pv[e] = __shfl_xor(v[e], LPH / 4);
    if (row < ML) {
        const int t = row & 4095, axis = d0 / (HD / 2), half = (d0 / NF) & 1, f0 = d0 % NF, pos = axis ? (t & 63) : (t >> 6);
        const float2* cs = tab + pos * NF + f0;
#pragma unroll
        for (int e = 0; e < 8; ++e) { const float2 c = cs[e]; v[e] = half ? (pv[e] * c.y + v[e] * c.x) : (v[e] * c.x - pv[e] * c.y); }
    }
    v4u o;
#pragma unroll
    for (int w = 0; w < 4; ++w) o[w] = pk2(v[2 * w] * oscale, v[2 * w + 1] * oscale);
    *(GAS v4u*)p = o;
}
template <int HD> __device__ __forceinline__ void qknorm_all(bf16* X, int ld, int nitems, const float* gain, float oscale, const float2* tab, int gw, int NGW, int lane) {
    const int parts = ld / 512;
    for (int it = gw * 4; it < nitems; it += NGW * 4) {
        v4u raw[4];
#pragma unroll
        for (int j = 0; j < 4; ++j) { const int item = it + j, row = item / parts, part = item % parts; raw[j] = *(const GAS v4u*)(X + (size_t)row * ld + (part * 64 + lane) * 8); }
#pragma unroll
        for (int j = 0; j < 4; ++j) qknorm_item<HD>(X, ld, it + j, raw[j], gain, oscale, tab, lane);
    }
}

__device__ __forceinline__ s16x4 vtr(const LAS unsigned char* p) { typedef short v4i16_t __attribute__((ext_vector_type(4))); return __builtin_bit_cast(s16x4, __builtin_amdgcn_ds_read_tr16_b64_v4i16((LAS v4i16_t*)p)); }
template <bool DIFF, int VAR = 0>
__device__ __forceinline__ void attn_phase(LAS unsigned char* lds, const bf16* Q, bf16* O, const bf16* K, const bf16* V, const bf16* Z, const int ldk,
                                           const float shift2, const float lam, const float* subnorm, const float* sink, const float oscale, const int G, const int vcu) {
    int tid_ = threadIdx.x; asm volatile("" : "+v"(tid_));
    const int tid = tid_, lane = tid & 63, wid = __builtin_amdgcn_readfirstlane(tid >> 6), r32 = lane & 31, hi = lane >> 5;
    constexpr int KSTR = 272, VSTR = 320, KBYTES = 64 * KSTR, STAGE = KBYTES + 64 * VSTR, XOFF = 0, WSOFF = 3 * STAGE;
    static_assert(WSOFF + 8 * 128 <= LDS_BARST && 65536 <= 3 * STAGE, "attention LDS map");
    constexpr int DSTEPS = DIFF ? 4 : 8;
    const int nunits = DIFF ? 128 * 34 : 2048;
    const int skey = tid >> 4, scc = tid & 15;
    LAS float* wsf = (LAS float*)(lds + WSOFF) + wid * 32;
    const int vrow = 4 * hi + ((lane & 15) >> 2), vcol = 16 * ((lane >> 4) & 1) + 4 * (lane & 3);
    for (int u = vcu, ui = 0; u < nunits; u += G, ++ui) {
        int nlat, lat0, ctx0, koff, myq0, qcol0, kd0, zcol0, kt0 = 0, qpos = 0, qb_ = 0; float sinkv = 0.f;
        if (DIFF) {
            int bh, qi; if (u < 4096) { bh = u >> 5; qi = u & 31; } else { bh = (u - 4096) >> 1; qi = 32 + ((u - 4096) & 1); }
            const int b = bh >> 5, h = bh & 31, m = wid >> 2, qs = wid & 3; (void)ui;
            int qrow0; if (qi < 32) { qrow0 = b * 4096 + 128 * qi; nlat = 64; } else { qrow0 = ML + b * 256 + 128 * (qi - 32); nlat = 0; }
            lat0 = b * 4096; ctx0 = ML + b * 256; koff = h * 128; myq0 = qrow0 + 32 * qs; qcol0 = h * 128 + 64 * m; kd0 = 64 * m; zcol0 = h * 128;
        } else {
            const int b = u >> 9, kvh = (u >> 6) & 7, qb = u & 63, g = wid >> 1, qs = wid & 1, head = kvh * 4 + g;
            kt0 = qb - 2 < 0 ? 0 : qb - 2; const int kt1 = qb + 2 > 63 ? 63 : qb + 2; nlat = kt1 - kt0 + 1;
            lat0 = b * 4096 + 64 * kt0; ctx0 = ML + b * 256; koff = kvh * 128; myq0 = b * 4096 + 64 * qb + 32 * qs; qcol0 = head * 128; kd0 = 0; zcol0 = head * 128;
            qpos = 64 * qb + 32 * qs + r32; sinkv = sink[head]; qb_ = qb;
        }
        const int nt = nlat + 4;
        bf16x8 qf[DSTEPS];
#pragma unroll
        for (int d = 0; d < DSTEPS; ++d) qf[d] = *(const GAS bf16x8*)(Q + (size_t)(myq0 + r32) * 4096 + qcol0 + 16 * d + 8 * hi);
        f32x16 o[4];
#pragma unroll
        for (int e = 0; e < 4; ++e)
#pragma unroll
            for (int r = 0; r < 16; ++r) o[e][r] = 0.f;
        float lsum = 0.f;
        v4u kreg[2], vreg[2];
#define ATT_TROW(tt) (((tt) < nlat) ? lat0 + 64 * (tt) : ctx0 + 64 * ((tt) - nlat))
#define ATT_LOAD(tt) do { const int r0_ = ATT_TROW(tt); _Pragma("unroll") for (int i = 0; i < 2; ++i) { const size_t go = (size_t)(r0_ + skey + 32 * i) * ldk + koff + 8 * scc; kreg[i] = *(const GAS v4u*)(K + go); vreg[i] = *(const GAS v4u*)(V + go); } } while (0)
#define ATT_WRITE(so) do { _Pragma("unroll") for (int i = 0; i < 2; ++i) { *(LAS v4u*)(lds + (so) + (skey + 32 * i) * KSTR + scc * 16) = kreg[i]; *(LAS v4u*)(lds + (so) + KBYTES + (skey + 32 * i) * VSTR + scc * 16) = vreg[i]; } } while (0)
#define ATT_QK(S0_, S1_, so) do { const LAS unsigned char* kp_ = lds + (so) + r32 * KSTR + (kd0 + 8 * hi) * 2; \
            _Pragma("unroll") for (int r = 0; r < 16; ++r) { S0_[r] = -shift2; S1_[r] = -shift2; } \
            _Pragma("unroll") for (int d = 0; d < DSTEPS; ++d) { const bf16x8 k0_ = *(const LAS bf16x8*)(kp_ + d * 32), k1_ = *(const LAS bf16x8*)(kp_ + 32 * KSTR + d * 32); \
                S0_ = __builtin_amdgcn_mfma_f32_32x32x16_bf16(k0_, qf[d], S0_, 0, 0, 0); S1_ = __builtin_amdgcn_mfma_f32_32x32x16_bf16(k1_, qf[d], S1_, 0, 0, 0); \
                } } while (0)
        ATT_LOAD(0); ATT_WRITE(0); ATT_LOAD(1); ATT_WRITE(STAGE); ATT_LOAD(2);
        __syncthreads();
        f32x16 s0, s1, n0, n1;
        constexpr bool PIPE = DIFF;
        if (PIPE) ATT_QK(s0, s1, 0);
        int so_c = 0, so_n = STAGE, so_w = 2 * STAGE;
        for (int t = 0; t < nt; ++t) {
            if (VAR != 2) { ATT_WRITE(so_w); const int tl = t + 3 < nt ? t + 3 : nt - 1; ATT_LOAD(tl); } __builtin_amdgcn_sched_barrier(0);
            if (PIPE) { const int so_q = t + 1 < nt ? so_n : so_c; ATT_QK(n0, n1, so_q); }
            else ATT_QK(s0, s1, so_c);
#pragma unroll
            for (int r = 0; r < 16; ++r) { if (VAR == 1) { s0[r] = s0[r] * 1.0001f + 0.5f; s1[r] = s1[r] * 1.0001f + 0.5f; } else { s0[r] = __builtin_amdgcn_exp2f(s0[r]); s1[r] = __builtin_amdgcn_exp2f(s1[r]); } }
            if (!DIFF && t < nlat && (kt0 + t == qb_ - 2 || kt0 + t == qb_ + 2)) { const int lim = 128; const int kb0 = 64 * (kt0 + t) - qpos;
#pragma unroll
                for (int r = 0; r < 16; ++r) { const int dd = kb0 + crow(r, hi); if (dd < -lim || dd > lim) s0[r] = 0.f; if (dd + 32 < -lim || dd + 32 > lim) s1[r] = 0.f; } }
            { float a = 0.f, b = 0.f;
#pragma unroll
              for (int r = 0; r < 16; ++r) { a += s0[r]; b += s1[r]; }
              lsum += a + b; }
            const LAS unsigned char* vp = lds + so_c + KBYTES + vrow * VSTR + vcol * 2;
#pragma unroll
            for (int kb = 0; kb < 2; ++kb)
#pragma unroll
                for (int sp = 0; sp < 2; ++sp) {
                    v4u pw;
#pragma unroll
                    for (int w = 0; w < 4; ++w) pw[w] = kb == 0 ? pk2(s0[8 * sp + 2 * w], s0[8 * sp + 2 * w + 1]) : pk2(s1[8 * sp + 2 * w], s1[8 * sp + 2 * w + 1]);
                    const bf16x8 pa = __builtin_bit_cast(bf16x8, pw);
#pragma unroll
                    for (int eb = 0; eb < 4; ++eb) {
                        bf16x8 vb;
                        if (VAR == 3) { vb = qf[(kb * 2 + sp + eb) & 3]; }
                        else { const s16x4 lo = vtr(vp + (32 * kb + 16 * sp) * VSTR + 64 * eb), hh = vtr(vp + (32 * kb + 16 * sp + 8) * VSTR + 64 * eb);
                        vb = (bf16x8){lo[0], lo[1], lo[2], lo[3], hh[0], hh[1], hh[2], hh[3]}; }
                        o[eb] = __builtin_amdgcn_mfma_f32_32x32x16_bf16(pa, vb, o[eb], 0, 0, 0); } }
            if (VAR != 4) __syncthreads();
            if (PIPE) { s0 = n0; s1 = n1; }
            { const int tmp = so_c; so_c = so_n; so_n = so_w; so_w = tmp; }
        }
#undef ATT_TROW
#undef ATT_LOAD
#undef ATT_WRITE
#undef ATT_QK
        float lt = lsum + __shfl_xor(lsum, 32);
        if (!DIFF) lt += __builtin_amdgcn_exp2f(sinkv * LOG2E - shift2);
        if (hi == 0) wsf[r32] = lt;
        LDS_WAIT();
        float rl[16];
#pragma unroll
        for (int r = 0; r < 16; ++r) rl[r] = 1.0f / wsf[crow(r, hi)];
        LDS_WAIT();
        if (DIFF) {
            LAS float* X = (LAS float*)(lds + XOFF) + (wid & 3) * 4096 + lane;
            if (wid >= 4) {
#pragma unroll
                for (int eb = 0; eb < 4; ++eb)
#pragma unroll
                    for (int r = 0; r < 16; ++r) X[(eb * 16 + r) * 64] = o[eb][r] * rl[r] * lam;
            }
            __syncthreads();
            if (wid < 4) {
                float ssq[16];
#pragma unroll
                for (int r = 0; r < 16; ++r) ssq[r] = 0.f;
#pragma unroll
                for (int eb = 0; eb < 4; ++eb)
#pragma unroll
                    for (int r = 0; r < 16; ++r) { const float v = o[eb][r] * rl[r] - X[(eb * 16 + r) * 64]; o[eb][r] = v; ssq[r] += v * v; }
#pragma unroll
                for (int r = 0; r < 16; ++r) { float s = ssq[r];
#pragma unroll
                    for (int of = 1; of < 32; of <<= 1) s += __shfl_xor(s, of);
                    ssq[r] = oscale / sqrtf(s * (1.0f / 128.0f) + EPS); }
#pragma unroll
                for (int eb = 0; eb < 4; ++eb) { const float gn = subnorm[32 * eb + r32];
                    unsigned zz[16];
#pragma unroll
                    for (int r = 0; r < 16; ++r) zz[r] = (unsigned)((const GAS bf16*)Z)[(size_t)(myq0 + crow(r, hi)) * 4096 + zcol0 + 32 * eb + r32];
#pragma unroll
                    for (int r = 0; r < 16; ++r) { const size_t off = (size_t)(myq0 + crow(r, hi)) * 4096 + zcol0 + 32 * eb + r32;
                        ((GAS bf16*)O)[off] = (bf16)f2bf(o[eb][r] * ssq[r] * gn * pg8::silu_f(bflo(zz[r]))); } }
            }
            __syncthreads();
        } else {
#pragma unroll
            for (int eb = 0; eb < 4; ++eb) { unsigned zz[16];
#pragma unroll
                for (int r = 0; r < 16; ++r) zz[r] = (unsigned)((const GAS bf16*)Z)[(size_t)(myq0 + crow(r, hi)) * 4096 + zcol0 + 32 * eb + r32];
#pragma unroll
                for (int r = 0; r < 16; ++r) { const size_t off = (size_t)(myq0 + crow(r, hi)) * 4096 + zcol0 + 32 * eb + r32;
                    ((GAS bf16*)O)[off] = (bf16)f2bf(o[eb][r] * rl[r] * pg8::silu_f(bflo(zz[r]))); } }
        }
    }
}

#define RLX_AGENT __ATOMIC_RELAXED, __HIP_MEMORY_SCOPE_AGENT
#define XB_TMO      128
#define XB_XCNT(j)  (256  + 64 * (j))
#define XB_XSUB(j)  (1280 + 64 * (j))
#define XB_XGEN(j)  (2304 + 64 * (j))
#define XB_TOP      3328
#define XB_TOPGEN   3392
#define XCD_BAR_WORDS 3456
#define XB_SPIN_CAP (1u << 18)

__device__ __forceinline__ unsigned xb_ld(unsigned* p)              { return __hip_atomic_load(p, __ATOMIC_RELAXED, __HIP_MEMORY_SCOPE_AGENT); }
__device__ __forceinline__ unsigned xb_add(unsigned* p, unsigned v) { return __hip_atomic_fetch_add(p, v, __ATOMIC_RELAXED, __HIP_MEMORY_SCOPE_AGENT); }
__device__ __forceinline__ unsigned xb_xcc_id() { return (unsigned)__builtin_amdgcn_s_getreg((3 << 11) | 20) & 0xFu; }
#define XB_SPIN(cond, bar) do { unsigned _sp = 0; while (cond) { __builtin_amdgcn_s_sleep(1); \
    if ((++_sp & 255u) == 0u) { if (xb_ld(&(bar)[XB_TMO])) break; if (_sp > XB_SPIN_CAP) { atomicAdd(&(bar)[XB_TMO], 1u); break; } } } } while (0)

struct XcdBarrier {
    unsigned* bar; unsigned x;
    volatile LAS unsigned* st;
};

__device__ __forceinline__ XcdBarrier xcd_barrier_post(unsigned* bar, volatile LAS unsigned* st) {
    XcdBarrier b; b.bar = bar; b.x = xb_xcc_id(); b.st = st;
    if (threadIdx.x == 0) (void)xb_add(&bar[XB_XCNT(b.x)], 1u);
    return b;
}
__device__ __forceinline__ void xcd_barrier_complete(unsigned* bar, unsigned x, unsigned& nloc, unsigned& nx) {
    const unsigned G = gridDim.x * gridDim.y * gridDim.z;
    unsigned sum, cnt, mine, sp = 0u;
    for (;;) {
        sum = 0u; cnt = 0u; mine = 0u;
#pragma unroll
        for (unsigned j = 0; j < 16; ++j) { const unsigned c = xb_ld(&bar[XB_XCNT(j)]); sum += c; cnt += (c > 0u) ? 1u : 0u; mine = (j == x) ? c : mine; }
        if (sum == G) break;
        __builtin_amdgcn_s_sleep(1);
        if ((++sp & 255u) == 0u) { if (xb_ld(&bar[XB_TMO])) break; if (sp > XB_SPIN_CAP) { atomicAdd(&bar[XB_TMO], 1u); break; } }
    }
    nloc = mine > 0u ? mine : 1u; nx = cnt > 0u ? cnt : 1u;
}

__device__ __forceinline__ void xcd_barrier(const XcdBarrier& b) {
    asm volatile("s_waitcnt vmcnt(0)" ::: "memory");
    __syncthreads();
    if (threadIdx.x == 0) {
        unsigned* bar = b.bar;
        __builtin_amdgcn_s_waitcnt(0);
        unsigned nloc = b.st[0], nx = b.st[1];
        if (nloc == 0u) { xcd_barrier_complete(bar, b.x, nloc, nx); b.st[0] = nloc; b.st[1] = nx; }
        const unsigned old = xb_add(&bar[XB_XSUB(b.x)], 1u);
        const unsigned gen = old / nloc;
        if (old + 1u == (gen + 1u) * nloc) {
            __builtin_amdgcn_fence(__ATOMIC_RELEASE, "agent");
            asm volatile("s_waitcnt vmcnt(0)" ::: "memory");
            const unsigned og = xb_add(&bar[XB_TOP], 1u);
            const unsigned tg = og / nx;
            if (og + 1u == (tg + 1u) * nx) xb_add(&bar[XB_TOPGEN], 1u);
            else XB_SPIN(xb_ld(&bar[XB_TOPGEN]) == tg, bar);
            __builtin_amdgcn_fence(__ATOMIC_ACQUIRE, "agent");
            xb_add(&bar[XB_XGEN(b.x)], 1u);
            asm volatile("s_waitcnt vmcnt(0)" ::: "memory");
        } else {
            XB_SPIN(xb_ld(&bar[XB_XGEN(b.x)]) == gen, bar);
            __builtin_amdgcn_fence(__ATOMIC_ACQUIRE, "agent");
            asm volatile("s_waitcnt vmcnt(0)" ::: "memory");
        }
    }
    __syncthreads();
}

#ifndef G2_ALIGN
#define G2_ALIGN false
#endif
#ifndef MK_SINGLE
#define MK_SINGLE 1
#endif
__global__ void __launch_bounds__(NWAVES * 64, 2) mk_fwd(Args a) {
    extern __shared__ __attribute__((aligned(16))) unsigned char lds_raw[];
    LAS unsigned char* lds = (LAS unsigned char*)lds_raw;
    cg::grid_group grid = cg::this_grid();
    const int lo = a.ph_lo, hi = a.ph_hi;
#define PHASE_LOCALS \
    int tid_ = threadIdx.x; asm volatile("" : "+v"(tid_)); const int tid = tid_, lane = tid & 63, wave = __builtin_amdgcn_readfirstlane(tid >> 6); (void)lane; (void)wave; \
    int G_ = gridDim.x, bx_ = blockIdx.x; asm volatile("" : "+s"(G_), "+s"(bx_)); const int G = G_, bx = bx_, vcu = (G % 8 == 0) ? (bx % 8) * (G / 8) + bx / 8 : bx; \
    const int gw = vcu * NWAVES + wave, NGW = G * NWAVES; (void)gw; (void)NGW; \
    unsigned char* ws_ = a.ws; asm volatile("" : "+s"(ws_)); unsigned char* ws = (unsigned char*)(GAS unsigned char*)ws_; \
    float* mod = (float*)(ws + WS_MOD); float2* tab64 = (float2*)(ws + WS_TAB); float2* tab128 = tab64 + 64 * 16; (void)mod; (void)tab64; (void)tab128; \
    bf16* WTin = (bf16*)(ws + WS_WTIN); bf16* WTout = (bf16*)(ws + WS_WTOUT); bf16* HA = (bf16*)(ws + WS_HA); float* cbuf = (float*)(ws + WS_CBUF); (void)WTin; (void)WTout; (void)HA; (void)cbuf; \
    bf16* S0 = (bf16*)(ws + WS_SLOT); bf16* S1 = (bf16*)(ws + WS_SLOT + SLOT_BYTES); bf16* S2 = (bf16*)(ws + WS_SLOT + 2 * SLOT_BYTES); bf16* S3 = (bf16*)(ws + WS_SLOT + 3 * SLOT_BYTES); (void)S0; (void)S1; (void)S2; (void)S3; \
    LAS float* scr = (LAS float*)(lds + wave * 16384); (void)scr;
#define IN(k) (lo <= (k) && (k) < hi)
#define SEAM(k) do { if ((k) + 1 < hi) { if ((k) == 0) grid.sync(); else { unsigned char* wsb_ = a.ws; asm volatile("" : "+s"(wsb_)); XcdBarrier bar_; bar_.bar = (unsigned*)(wsb_ + WS_BAR); bar_.x = xb_xcc_id(); bar_.st = (volatile LAS unsigned*)(lds + LDS_BARST); xcd_barrier(bar_); } } } while (0)
    if (hi - lo > 1) {
        if (threadIdx.x < 2) ((volatile LAS unsigned*)(lds + LDS_BARST))[threadIdx.x] = 0u;
        __syncthreads();
        unsigned char* wsb_ = a.ws; (void)xcd_barrier_post((unsigned*)(wsb_ + WS_BAR), (volatile LAS unsigned*)(lds + LDS_BARST));
    }

    if (IN(0)) { PHASE_LOCALS
        transpose_all<MAP_CONV>(argp(7), DM, 4 * DI, WTin, scr, gw, NGW, lane);
        transpose_all<MAP_ID>(argp(10), DI, DM, WTout, scr, gw, NGW, lane);
        for (int it = gw; it < 6144; it += NGW) mod_item(mod, scr, it, lane);
        if (bx == 0) {
            for (int i = tid; i < 64 * 16; i += NWAVES * 64) { const int pos = i >> 4, f = i & 15; const float ang = (float)pos * exp2f(-(float)f * (13.287712379549449f / 16.0f)); tab64[i] = make_float2(cosf(ang), sinf(ang)); }
            for (int i = tid; i < 64 * 32; i += NWAVES * 64) { const int pos = i >> 5, f = i & 31; const float ang = (float)pos * exp2f(-(float)f * (13.287712379549449f / 32.0f)); tab128[i] = make_float2(cosf(ang), sinf(ang)); }
        }
        SEAM(0);
    }
#pragma unroll
    for (int l = 0; l < 4; ++l) {
        const int base = 1 + 5 * l, kind = (l == 3) ? 0 : l;
        const int LB = l == 0 ? 4 : l == 1 ? 11 : l == 2 ? 23 : 31, LW = l == 0 ? 10 : l == 1 ? 22 : l == 2 ? 30 : 37;
#define XCUR (l == 0 ? argp(0) : (const float*)(const GAS float*)a.out)
#define CCUR (l == 0 ? argp(2) : (const float*)cbuf)
        const int m1 = (l == 3) ? ML : MT;
        if (IN(base)) { PHASE_LOCALS
            if (l > 0) {
                if (kind == 0) transpose_all<MAP_CONV>(argp(LB + 3), DM, 4 * DI, WTin, scr, gw, NGW, lane);
                else if (kind == 1) transpose_all<MAP_DIFF>(argp(LB + 3), DM, 4 * DI, WTin, scr, gw, NGW, lane);
                else transpose_all<MAP_WIN>(argp(LB + 3), DM, 2 * DI + 2048, WTin, scr, gw, NGW, lane);
                transpose_all<MAP_ID>(argp(LW), DI, DM, WTout, scr, gw, NGW, lane);
            }
            const float* xc = XCUR; const float* cc = CCUR; const float* ng = argp(LB);
            float* slab = (float*)(ws + WS_SLAB); (void)slab;
            for (int row = gw; row < m1; row += NGW) { const bool lat = row < ML;
                if (lat || l == 0) norm_row(lat ? xc + (size_t)row * DM : cc + (size_t)(row - ML) * DM, ng, mod + (size_t)(l * 5 + (lat ? (row >> 12) : 4)) * 6144, HA + (size_t)row * DM, lane);
                else { const float* prev = l == 1 ? argp(2) : (const float*)cbuf;
                    norm_row(prev + (size_t)(row - ML) * DM, ng, mod + (size_t)(l * 5 + 4) * 6144, HA + (size_t)row * DM, lane, slab + (size_t)(row - ML) * DM, mod + (size_t)((l - 1) * 5 + 4) * 6144 + 4096, cbuf + (size_t)(row - ML) * DM); } }
            SEAM(base);
        }
        if (IN(base + 1)) { PHASE_LOCALS
            if (kind == 0) { pg8::Gemm g{HA, WTin, m1, 4 * DI, DM}; pg8::StaticOrder S; S.init(m1, 4 * DI, G, bx); pg8::EpiConvF E{S2, (float*)(ws + WS_HALO), argp(LB + 4), argp(LB + 5), (LAS float*)(lds + 131072), m1 / 256};

                pg8::gemm_phase<pg8::EpiConvF, pg8::StaticOrder, true, true>(lds, g, S, E);
 }
            else if (kind == 1) { pg8::Gemm g{HA, WTin, m1, 4 * DI, DM}; pg8::StaticOrder S; S.init(m1, 4 * DI, G, bx); typedef pg8::EpiDiff<(long)(SLOT_BYTES / 2)> EpiS1; EpiS1 E{S0, argp(LB + 4), argp(LB + 5), (const float*)tab64, 0.125f * LOG2E};

                pg8::gemm_phase<EpiS1, pg8::StaticOrder, true, true>(lds, g, S, E);
 }
            else { pg8::Gemm g{HA, WTin, m1, 2 * DI + 2048, DM}; pg8::StaticOrder S; S.init(m1, 2 * DI + 2048, G, bx); typedef pg8::EpiWin<(long)(SLOT_BYTES / 2), (long)MT> EpiS2; EpiS2 E{S0, argp(LB + 4), argp(LB + 5), (const float*)tab128, 0.08838834764831845f * LOG2E, (LAS float*)(lds + 131072)};

                pg8::gemm_phase<EpiS2, pg8::StaticOrder, true, true>(lds, g, S, E);
 }
            SEAM(base + 1);
        }
        if (kind == 0 && IN(base + 2)) { PHASE_LOCALS
            if (kind == 0) { for (int it = bx; it < (m1 / 256) * 2; it += G) convfix_item(S2, (const float*)(ws + WS_HALO), argp(LB + 4), m1 / 256, it, tid); }
            else if (kind == 1) {
                qknorm_all<64>(S0, DI, MT * 8, argp(LB + 4), 0.125f * LOG2E, tab64, gw, NGW, lane);
                qknorm_all<64>(S1, DI, MT * 8, argp(LB + 5), 1.0f, tab64, gw, NGW, lane);
            } else {
                qknorm_all<128>(S0, DI, ML * 8, argp(LB + 4), 0.08838834764831845f * LOG2E, tab128, gw, NGW, lane);
                qknorm_all<128>(S1, 1024, MT * 2, argp(LB + 5), 1.0f, tab128, gw, NGW, lane);
            }
            SEAM(base + 2);
        }
        if (kind != 0 && IN(base + 3)) { PHASE_LOCALS
            if (kind == 1) {
                const float gq = wave_max(fabsf(argp(LB + 4)[lane])), gk = wave_max(fabsf(argp(LB + 5)[lane]));
                const float d1 = wave_sum(argp(LB + 6)[lane] * argp(LB + 7)[lane]), d2 = wave_sum(argp(LB + 8)[lane] * argp(LB + 9)[lane]);
                const float lam = expf(d1) - expf(d2) + LAM_INIT1;
                attn_phase<true>(lds, S0, S0, S1, S2, S3, DI, 8.0f * gq * gk * LOG2E, lam, argp(LB + 10), nullptr, 1.0f - LAM_INIT1, G, vcu);
            } else {
                const float gq = wave_max(fmaxf(fabsf(argp(LB + 4)[lane]), fabsf(argp(LB + 4)[lane + 64]))), gk = wave_max(fmaxf(fabsf(argp(LB + 5)[lane]), fabsf(argp(LB + 5)[lane + 64])));
                attn_phase<false>(lds, S0, S0, S1, S1 + (size_t)MT * 1024, S3, 1024, 11.313708498984761f * gq * gk * LOG2E, 0.f, nullptr, argp(LB + 6), 1.0f, G, vcu);
            }
            SEAM(base + 3);
        }
        if (IN(base + 4)) { PHASE_LOCALS
            { pg8::Gemm g{kind == 0 ? S2 : S0, WTout, ML, DM, DI}; pg8::StaticOrder S; S.init(ML, DM, G, bx);
              pg8::EpiResid E{XCUR, (float*)(GAS float*)a.out, mod + (size_t)l * 5 * 6144};
              pg8::gemm_phase<pg8::EpiResid, pg8::StaticOrder, G2_ALIGN, true>(lds, g, S, E);
            }
            if (l < 2) {
                pg8::Gemm g{kind == 0 ? S2 : S0, WTout, MT, DM, 512, DI}; pg8::SplitOrder S{bx, G}; pg8::EpiSlab E{(float*)(ws + WS_SLAB)};
                pg8::gemm_phase<pg8::EpiSlab, pg8::SplitOrder, true, true>(lds, g, S, E);
            }
            SEAM(base + 4);
        }
    }
#undef IN
#undef SEAM
}

extern "C" void kernel_launch(void* const* d_in, const int* in_sizes, int n_in, void* d_out, int out_size, void* d_ws, size_t ws_size, hipStream_t stream) {
    static int grid = 0;
    if (grid == 0) {
        if (n_in != 38 || in_sizes[0] != ML * DM || out_size != ML * DM || ws_size < WS_END) { fprintf(stderr, "kernel_launch: unexpected shapes (n_in %d, out %d, ws %zu < %zu)\n", n_in, out_size, ws_size, (size_t)WS_END); grid = -1; return; }
        int dev = 0, cus = 0, per_cu = 0;
        if (hipGetDevice(&dev) != hipSuccess || hipDeviceGetAttribute(&cus, hipDeviceAttributeMultiprocessorCount, dev) != hipSuccess) { grid = -1; return; }
        if (hipFuncSetAttribute((const void*)mk_fwd, hipFuncAttributeMaxDynamicSharedMemorySize, LDS_BYTES) != hipSuccess) { fprintf(stderr, "kernel_launch: hipFuncSetAttribute failed\n"); grid = -1; return; }
        if (hipOccupancyMaxActiveBlocksPerMultiprocessor(&per_cu, (const void*)mk_fwd, NWAVES * 64, LDS_BYTES) != hipSuccess || per_cu < 1) { fprintf(stderr, "kernel_launch: occupancy query says %d\n", per_cu); per_cu = 1; }
        (void)hipGetLastError();
        grid = cus;
    }
    if (grid < 0) return;
    (void)hipMemsetAsync((char*)d_ws + WS_MOD, 0, MOD_ZERO_BYTES, stream);
    Args a{};
    for (int i = 0; i < 38; ++i) a.in[i] = (const float*)d_in[i];
    a.out = (float*)d_out; a.ws = (unsigned char*)d_ws;
#if MK_SINGLE
    a.ph_lo = 0; a.ph_hi = NPH;
    void* params[] = {&a};
    const hipError_t e = hipLaunchCooperativeKernel((const void*)mk_fwd, dim3(grid), dim3(NWAVES * 64), params, LDS_BYTES, stream);
    if (e != hipSuccess) fprintf(stderr, "kernel_launch: cooperative launch failed: %s (grid %d)\n", hipGetErrorString(e), grid);
#else
    for (int ph = 0; ph < NPH; ++ph) {
        if (ph == 4 || ph == 19) continue;
        a.ph_lo = ph; a.ph_hi = ph + 1;
        hipLaunchKernelGGL(mk_fwd, dim3(grid), dim3(NWAVES * 64), LDS_BYTES, stream, a);
    }
#endif
}
```
